# Optimizing an MI355X kernel written in HIP

```python
import math
import jax, jax.numpy as jnp
from jax import lax
import numpy as np

D_MODEL = 1024
BATCH = 4
SEQ = 8192
DEPTH = 2

D_MIX = D_MODEL
A_WIDTH = D_MIX // 2
A_HEAD_DIM = 128
A_HEADS = A_WIDTH // A_HEAD_DIM
B_WIDTH = D_MIX - A_WIDTH
B_GROUPS = 4
B_GROUP_DIM = B_WIDTH // B_GROUPS
D_IN = 4 * A_WIDTH + 2 * B_WIDTH
D_FF = int(math.ceil(8 * D_MODEL / 3 / 128)) * 128
SPATIAL_CHUNK = 128
RECUR_CHUNK = 64
FFN_RES = 0.5
EPS = 1e-6
F_MIN = 1e-20

kernel_name = "hybrid_hgrn2_gmlp_macaron"


def rmsnorm(x, g):
    xf = x.astype(jnp.float32)
    y = xf * lax.rsqrt(jnp.mean(xf * xf, axis=-1, keepdims=True) + EPS)
    return (y * g.astype(jnp.float32)).astype(x.dtype)


def layernorm(x, g, b):
    xf = x.astype(jnp.float32)
    mu = jnp.mean(xf, axis=-1, keepdims=True)
    var = jnp.mean(jnp.square(xf - mu), axis=-1, keepdims=True)
    y = (xf - mu) * lax.rsqrt(var + EPS)
    return (y * g.astype(jnp.float32) + b.astype(jnp.float32)).astype(x.dtype)


def swiglu_ffn(h, w_gate, w_up, w_down):
    return (jax.nn.silu(h @ w_gate) * (h @ w_up)) @ w_down


def hgrn2_mixer(q_in, f_in, i_in, g_in, lb, norm_g):
    bsz, seq, _ = q_in.shape
    dt = q_in.dtype
    n_chunks = seq // RECUR_CHUNK
    zf = f_in.astype(jnp.float32)
    lb32 = lb.astype(jnp.float32)
    f = lb32 + (1.0 - lb32) * jax.nn.sigmoid(zf)
    log_f = jnp.log(jnp.maximum(f, F_MIN))
    k_in = (1.0 - lb32) * jax.nn.sigmoid(-zf)

    def to_chunks(t):
        return t.astype(jnp.float32).reshape(bsz, n_chunks, RECUR_CHUNK, A_HEADS, A_HEAD_DIM).transpose(1, 0, 3, 2, 4)

    causal = jnp.tril(jnp.ones((RECUR_CHUNK, RECUR_CHUNK), dtype=bool))[:, :, None]

    def step(state, inp):
        q, k, lf, v = inp
        a = jnp.cumsum(lf, axis=2)
        rel = a[:, :, :, None, :] - a[:, :, None, :, :]
        decay = jnp.where(causal, jnp.exp(jnp.where(causal, rel, 0.0)), 0.0)
        scores = jnp.einsum('bhtk,bhsk,bhtsk->bhts', q, k, decay)
        o = jnp.einsum('bhts,bhsv->bhtv', scores, v)
        o = o + jnp.einsum('bhtk,bhkv->bhtv', q * jnp.exp(a), state)
        a_last = a[:, :, -1:, :]
        k_dec = k * jnp.exp(a_last - a)
        new_state = jnp.exp(a_last[:, :, 0, :])[..., None] * state + jnp.einsum('bhsk,bhsv->bhkv', k_dec, v)
        return new_state, o

    s0 = jnp.zeros((bsz, A_HEADS, A_HEAD_DIM, A_HEAD_DIM), jnp.float32)
    _, o = lax.scan(step, s0, (to_chunks(q_in), to_chunks(k_in), to_chunks(log_f), to_chunks(i_in)))
    o = o.transpose(1, 0, 3, 2, 4).reshape(bsz, seq, A_HEADS, A_HEAD_DIM)
    o = o * lax.rsqrt(jnp.mean(o * o, axis=-1, keepdims=True) + EPS)
    o = o.reshape(bsz, seq, A_WIDTH) * norm_g.astype(jnp.float32)
    o = o * jax.nn.silu(g_in.astype(jnp.float32))
    return o.astype(dt)


def gmlp_mixer(u_in, v_in, ln_g, ln_b, w_spatial, b_spatial):
    bsz, seq, _ = u_in.shape
    u = jax.nn.gelu(u_in)
    v = layernorm(jax.nn.gelu(v_in), ln_g, ln_b)
    vr = v.reshape(bsz, seq // SPATIAL_CHUNK, SPATIAL_CHUNK, B_GROUPS, B_GROUP_DIM)
    w = jnp.where(jnp.tril(jnp.ones((SPATIAL_CHUNK, SPATIAL_CHUNK), dtype=bool))[None], w_spatial, 0.0).astype(v.dtype)
    s = jnp.einsum('gts,bnsgc->bntgc', w, vr) + b_spatial.T[None, None, :, :, None].astype(v.dtype)
    return u * s.reshape(bsz, seq, B_WIDTH)


def setup_inputs(seed: int = 0) -> dict:
    key = jax.random.key(seed)
    ks = jax.random.split(key, 24)
    f32 = jnp.float32

    def nrm(k, shape, scale):
        return jax.random.normal(k, shape, f32) * scale

    def gain(k, shape):
        return 1.0 + 0.01 * jax.random.normal(k, shape, f32)

    return {
        "x": nrm(ks[0], (BATCH, SEQ, D_MODEL), 1.0),
        "norm_ffn1": gain(ks[1], (DEPTH, D_MODEL)),
        "ffn1_w_gate": nrm(ks[2], (DEPTH, D_MODEL, D_FF), D_MODEL ** -0.5),
        "ffn1_w_up": nrm(ks[3], (DEPTH, D_MODEL, D_FF), D_MODEL ** -0.5),
        "ffn1_w_down": nrm(ks[4], (DEPTH, D_FF, D_MODEL), D_FF ** -0.5),
        "norm_mix": gain(ks[5], (DEPTH, D_MODEL)),
        "w_in": nrm(ks[6], (DEPTH, D_MODEL, D_IN), D_MODEL ** -0.5),
        "lb_param": nrm(ks[7], (DEPTH, A_WIDTH), 0.1),
        "hgrn_norm": gain(ks[8], (DEPTH, A_WIDTH)),
        "ln_v_gain": gain(ks[9], (DEPTH, B_WIDTH)),
        "ln_v_bias": nrm(ks[10], (DEPTH, B_WIDTH), 0.01),
        "w_spatial": nrm(ks[11], (DEPTH, B_GROUPS, SPATIAL_CHUNK, SPATIAL_CHUNK), 0.5 * SPATIAL_CHUNK ** -0.5),
        "b_spatial": gain(ks[12], (DEPTH, B_GROUPS, SPATIAL_CHUNK)),
        "w_out": nrm(ks[13], (DEPTH, D_MIX, D_MODEL), D_MIX ** -0.5),
        "norm_ffn2": gain(ks[14], (DEPTH, D_MODEL)),
        "ffn2_w_gate": nrm(ks[15], (DEPTH, D_MODEL, D_FF), D_MODEL ** -0.5),
        "ffn2_w_up": nrm(ks[16], (DEPTH, D_MODEL, D_FF), D_MODEL ** -0.5),
        "ffn2_w_down": nrm(ks[17], (DEPTH, D_FF, D_MODEL), D_FF ** -0.5),
        "norm_final": gain(ks[18], (D_MODEL,)),
    }


def reference(x, norm_ffn1, ffn1_w_gate, ffn1_w_up, ffn1_w_down, norm_mix, w_in, lb_param, hgrn_norm,
              ln_v_gain, ln_v_bias, w_spatial, b_spatial, w_out, norm_ffn2, ffn2_w_gate, ffn2_w_up,
              ffn2_w_down, norm_final):
    p = jax.nn.softmax(lb_param.astype(jnp.float32), axis=0)
    lbs = jnp.cumsum(p, axis=0) - p[0]
    split_idx = [A_WIDTH, 2 * A_WIDTH, 3 * A_WIDTH, 4 * A_WIDTH, 4 * A_WIDTH + B_WIDTH]
    for l in range(DEPTH):
        x = x + FFN_RES * swiglu_ffn(rmsnorm(x, norm_ffn1[l]), ffn1_w_gate[l], ffn1_w_up[l], ffn1_w_down[l])
        h = rmsnorm(x, norm_mix[l])
        q_a, f_a, i_a, g_a, u_b, v_b = jnp.split(h @ w_in[l], split_idx, axis=-1)
        o_a = hgrn2_mixer(q_a, f_a, i_a, g_a, lbs[l], hgrn_norm[l])
        o_b = gmlp_mixer(u_b, v_b, ln_v_gain[l], ln_v_bias[l], w_spatial[l], b_spatial[l])
        x = x + jnp.concatenate([o_a, o_b], axis=-1) @ w_out[l]
        x = x + FFN_RES * swiglu_ffn(rmsnorm(x, norm_ffn2[l]), ffn2_w_gate[l], ffn2_w_up[l], ffn2_w_down[l])
    return rmsnorm(x, norm_final)
```

```cpp
#include <hip/hip_runtime.h>
#include <hip/hip_cooperative_groups.h>
#include <cstdio>
#include <cstdint>
namespace cg = cooperative_groups;
namespace pg8 {
#define PG8_LAS __attribute__((address_space(3)))
typedef unsigned short bf16_t;
typedef short bf16x8 __attribute__((ext_vector_type(8)));
typedef float f32x4 __attribute__((ext_vector_type(4)));
typedef unsigned u32x4 __attribute__((ext_vector_type(4)));
constexpr int BM = 256, BK = 64, HALF = 128, HTB = HALF * BK * 2  , STAGE_BYTES = 8 * HTB, NXCD = 8, WGM = 8;

__host__ __device__ __forceinline__ int lds_byte(int r, int c) { const int st = (r >> 4) * 2 + (c >> 5), rr = r & 15, cc = c & 31, ob = rr * 64 + cc * 2; return st * 1024 + (ob ^ (((ob >> 9) & 1) << 5)); }
__host__ __device__ __forceinline__ void stage_rc(int b, int& R, int& C) { const int st = b / 1024, sb = b % 1024, swz = sb ^ (((sb >> 9) & 1) << 5); R = (st >> 1) * 16 + swz / 64; C = (st & 1) * 32 + (swz % 64) / 2; }
__host__ __device__ __forceinline__ int perm32(int rho) { const int n = rho >> 4, i = rho & 15; return 8 * (i >> 2) + 4 * n + (i & 3); }

struct Unit { int pm, pn; };
struct Gemm { const bf16_t* A; const bf16_t* Bt; int M, N, K; };

struct StaticOrder {
    int nM, nN, nwg, G, c;
    __host__ __device__ void init(int M, int N, int G_, int c_) { nM = M / BM; nN = N / BM; nwg = nM * nN; G = G_; c = c_; }
    __host__ __device__ bool next(int i, Unit& u) const {
        const long L = (long)i * G + c; if (L >= nwg) return false;
        int wgid = (int)L; { const int q = nwg / NXCD, r = nwg % NXCD, xcd = wgid % NXCD, off = wgid / NXCD; wgid = (xcd < r ? xcd * (q + 1) : r * (q + 1) + (xcd - r) * q) + off; }
        const int nig = WGM * nN, gid = wgid / nig, fm = gid * WGM, gsz = (nM - fm) < WGM ? (nM - fm) : WGM;
        u.pm = fm + ((wgid % nig) % gsz); u.pn = (wgid % nig) / gsz; return true;
    }
    __device__ __forceinline__ void a_ready(const Unit&) const {}
    __device__ __forceinline__ void done(const Unit&) const {}
};

typedef __bf16 bf16v2_t __attribute__((ext_vector_type(2))); typedef float f32x2_t __attribute__((ext_vector_type(2)));
__device__ __forceinline__ unsigned cvt_pk_bf16(float lo, float hi) { bf16v2_t r = __builtin_convertvector((f32x2_t){lo, hi}, bf16v2_t); return __builtin_bit_cast(unsigned, r); }
typedef float f32x2 __attribute__((ext_vector_type(2)));
template <class Epi, class Sched, bool ALIGN_EPI = false, bool SP2 = false>
__device__ __forceinline__ void gemm_phase(PG8_LAS unsigned char* lds, const Gemm g, const Sched& S, const Epi& E) {
    int tid_ = threadIdx.x; asm volatile("" : "+v"(tid_));
    const int tid = tid_, wid = __builtin_amdgcn_readfirstlane(tid >> 6), lane = tid & 63, wr = wid >> 2, wc = wid & 3, fr = lane & 15, fq = lane >> 4;
    const int K = g.K, nt = K / BK;
    unsigned voffA[2], voffB[2];
#pragma unroll
    for (int i = 0; i < 2; ++i) { int R, C; stage_rc(tid * 16 + i * 8192, R, C); const int Rb = Epi::PERM ? ((R & ~31) + perm32(R & 31)) : R;
        voffA[i] = (unsigned)(R * K + C) * 2u; voffB[i] = (unsigned)(Rb * K + C) * 2u; }
    const size_t kstep = (size_t)(BK * 2);
    const size_t hstep = (size_t)HALF * K * 2;
    const size_t tstep = 2 * hstep;
    const unsigned ldsw = (unsigned)wid * 1024u;
    const int aoff = lds_byte(wr * 64 + fr, fq * 8), boff = lds_byte(wc * 32 + fr, fq * 8);
#define PG8_SA(b, h) (((b) * 2 + (h)) * HTB)
#define PG8_SB(b, h) ((4 + (b) * 2 + (h)) * HTB)
#define PG8_STAGE(bufoff, gbase, voff) do { _Pragma("unroll") for (int _i = 0; _i < 2; ++_i) \
        __builtin_amdgcn_global_load_lds((const unsigned*)((const char*)(gbase) + (voff)[_i]), (PG8_LAS unsigned*)(lds + (bufoff) + ldsw + _i * 8192), 16, 0, 0); } while (0)
#define PG8_LDA(dst, b, h) do { _Pragma("unroll") for (int m = 0; m < 4; ++m) _Pragma("unroll") for (int k = 0; k < 2; ++k) dst[m][k] = *(const PG8_LAS bf16x8*)(lds + PG8_SA(b, h) + aoff + m * 2048 + k * 1024); } while (0)
#define PG8_LDB(dst, b, h) do { _Pragma("unroll") for (int n = 0; n < 2; ++n) _Pragma("unroll") for (int k = 0; k < 2; ++k) dst[n][k] = *(const PG8_LAS bf16x8*)(lds + PG8_SB(b, h) + boff + n * 2048 + k * 1024); } while (0)
#define PG8_MMA(ai, bj, At, Bt) do { __builtin_amdgcn_s_setprio(1); _Pragma("unroll") for (int m = 0; m < 4; ++m) _Pragma("unroll") for (int n = 0; n < 2; ++n) _Pragma("unroll") for (int k = 0; k < 2; ++k) \
        acc[ai][bj][m][n] = __builtin_amdgcn_mfma_f32_16x16x32_bf16(Bt[n][k], At[m][k], acc[ai][bj][m][n], 0, 0, 0); __builtin_amdgcn_s_setprio(0); } while (0)
#define PG8_WAIT_V(n) asm volatile("s_waitcnt vmcnt(" #n ")" ::: "memory")
#define PG8_WAIT_L(n) asm volatile("s_waitcnt lgkmcnt(" #n ")" ::: "memory")
#define PG8_BAR __builtin_amdgcn_s_barrier()
#define PG8_SCHED __builtin_amdgcn_sched_barrier(0)
    Unit cur, nxt; int ui = 0;
    if (!S.next(0, cur)) return;
    f32x4 acc[2][2][4][2];
#pragma unroll
    for (int a = 0; a < 2; ++a)
#pragma unroll
        for (int b = 0; b < 2; ++b)
#pragma unroll
            for (int m = 0; m < 4; ++m)
#pragma unroll
                for (int n = 0; n < 2; ++n) acc[a][b][m][n] = (f32x4){0.f, 0.f, 0.f, 0.f};
    bf16x8 At[4][2], B0[2][2], B1[2][2];
    const char* cA = (const char*)g.A + (size_t)cur.pm * tstep; const char* cB = (const char*)g.Bt + (size_t)cur.pn * tstep;
    S.a_ready(cur);
    if constexpr (SP2) {
        PG8_STAGE(PG8_SB(0, 0), cB, voffB); PG8_STAGE(PG8_SB(0, 1), cB + hstep, voffB); PG8_STAGE(PG8_SA(0, 0), cA, voffA); PG8_STAGE(PG8_SA(0, 1), cA + hstep, voffA);
        if (wr == 1) PG8_BAR;
        PG8_WAIT_V(2); PG8_BAR;
        PG8_STAGE(PG8_SB(1, 0), cB + kstep, voffB); PG8_STAGE(PG8_SA(1, 0), cA + kstep, voffA); PG8_STAGE(PG8_SB(1, 1), cB + hstep + kstep, voffB);
        PG8_WAIT_V(6); PG8_BAR;
    } else {
        PG8_STAGE(PG8_SB(0, 0), cB, voffB); PG8_STAGE(PG8_SA(0, 0), cA, voffA); PG8_STAGE(PG8_SB(0, 1), cB + hstep, voffB); PG8_STAGE(PG8_SA(0, 1), cA + hstep, voffA);
        if (wr == 1) PG8_BAR;
        PG8_WAIT_V(4); PG8_BAR;
        PG8_STAGE(PG8_SB(1, 0), cB + kstep, voffB); PG8_STAGE(PG8_SA(1, 0), cA + kstep, voffA); PG8_STAGE(PG8_SB(1, 1), cB + hstep + kstep, voffB);
        PG8_WAIT_V(6); PG8_BAR;
    }
    for (;;) {
        const bool has_next = S.next(ui + 1, nxt);
        const char* nA = has_next ? (const char*)g.A + (size_t)nxt.pm * tstep : cA; const char* nB = has_next ? (const char*)g.Bt + (size_t)nxt.pn * tstep : cB;
        for (int t = 0; t < nt; t += 2) {
            const bool last = (t == nt - 2);
            const char* a1 = cA + (size_t)(t + 1) * kstep;
            const char* a2 = last ? nA : cA + (size_t)(t + 2) * kstep; const char* b2 = last ? nB : cB + (size_t)(t + 2) * kstep;
            const char* a3 = a2 + kstep; const char* b3 = b2 + kstep;
            if (last && has_next) S.a_ready(nxt);
            if constexpr (SP2) {
            PG8_LDB(B0, 0, 0); PG8_LDB(B1, 0, 1); PG8_SCHED; PG8_LDA(At, 0, 0); PG8_STAGE(PG8_SA(1, 1), a1 + hstep, voffA);
            PG8_WAIT_V(8); PG8_WAIT_L(0); PG8_BAR; PG8_MMA(0, 0, At, B0); PG8_MMA(0, 1, At, B1); PG8_BAR; PG8_SCHED;
            PG8_LDA(At, 0, 1); PG8_STAGE(PG8_SB(0, 0), b2, voffB); PG8_STAGE(PG8_SB(0, 1), b2 + hstep, voffB); PG8_STAGE(PG8_SA(0, 0), a2, voffA);
            PG8_WAIT_V(8); PG8_WAIT_L(0); PG8_BAR; PG8_MMA(1, 0, At, B0); PG8_MMA(1, 1, At, B1); PG8_BAR; PG8_SCHED;
            PG8_LDB(B0, 1, 0); PG8_LDB(B1, 1, 1); PG8_SCHED; PG8_LDA(At, 1, 0); PG8_STAGE(PG8_SA(0, 1), a2 + hstep, voffA);
            PG8_WAIT_V(8); PG8_WAIT_L(0); PG8_BAR; PG8_MMA(0, 0, At, B0); PG8_MMA(0, 1, At, B1); PG8_BAR; PG8_SCHED;
            PG8_LDA(At, 1, 1); PG8_STAGE(PG8_SB(1, 0), b3, voffB); PG8_STAGE(PG8_SB(1, 1), b3 + hstep, voffB); PG8_STAGE(PG8_SA(1, 0), a3, voffA);
            PG8_WAIT_V(8); PG8_WAIT_L(0); PG8_BAR; PG8_MMA(1, 0, At, B0); PG8_MMA(1, 1, At, B1); PG8_BAR; PG8_SCHED;
            } else {
            PG8_LDB(B0, 0, 0); PG8_SCHED; PG8_LDA(At, 0, 0); PG8_STAGE(PG8_SA(1, 1), a1 + hstep, voffA);
            PG8_WAIT_L(8); PG8_BAR; PG8_WAIT_L(0); PG8_MMA(0, 0, At, B0); PG8_BAR; PG8_SCHED;
            PG8_LDB(B1, 0, 1); PG8_STAGE(PG8_SB(0, 0), b2, voffB);
            PG8_BAR; PG8_WAIT_L(0); PG8_MMA(0, 1, At, B1); PG8_BAR;
            PG8_LDA(At, 0, 1); PG8_STAGE(PG8_SA(0, 0), a2, voffA);
            PG8_BAR; PG8_WAIT_L(0); PG8_MMA(1, 0, At, B0); PG8_BAR; PG8_SCHED;
            PG8_STAGE(PG8_SB(0, 1), b2 + hstep, voffB);
            PG8_WAIT_V(6); PG8_BAR; PG8_MMA(1, 1, At, B1); PG8_BAR;
            PG8_LDB(B0, 1, 0); PG8_SCHED; PG8_LDA(At, 1, 0); PG8_STAGE(PG8_SA(0, 1), a2 + hstep, voffA);
            PG8_WAIT_L(8); PG8_BAR; PG8_WAIT_L(0); PG8_MMA(0, 0, At, B0); PG8_BAR; PG8_SCHED;
            PG8_LDB(B1, 1, 1); PG8_STAGE(PG8_SB(1, 0), b3, voffB);
            PG8_BAR; PG8_WAIT_L(0); PG8_MMA(0, 1, At, B1); PG8_BAR;
            PG8_LDA(At, 1, 1); PG8_STAGE(PG8_SA(1, 0), a3, voffA);
            PG8_BAR; PG8_WAIT_L(0); PG8_MMA(1, 0, At, B0); PG8_BAR; PG8_SCHED;
            PG8_STAGE(PG8_SB(1, 1), b3 + hstep, voffB);
            PG8_WAIT_V(6); PG8_BAR; PG8_MMA(1, 1, At, B1); PG8_BAR;
            }
        }
        if constexpr (ALIGN_EPI) { if (wr == 0) PG8_BAR; }
        if constexpr (!Epi::AFTER_DRAIN) { E(acc, cur, wr, wc, fr, fq); S.done(cur); }
        if (!has_next) break;
#pragma unroll
        for (int a = 0; a < 2; ++a)
#pragma unroll
            for (int b = 0; b < 2; ++b)
#pragma unroll
                for (int m = 0; m < 4; ++m)
#pragma unroll
                    for (int n = 0; n < 2; ++n) acc[a][b][m][n] = (f32x4){0.f, 0.f, 0.f, 0.f};
        cur = nxt; cA = nA; cB = nB; ++ui;
        if constexpr (ALIGN_EPI) { if (wr == 1) PG8_BAR; }
    }
    PG8_WAIT_V(0);
    if constexpr (!ALIGN_EPI) { if (wr == 0) PG8_BAR; }
    PG8_BAR;
    if constexpr (Epi::AFTER_DRAIN) { E.fused(acc, cur, wr, wc, fr, fq, lds, wid, lane); S.done(cur); }
#undef PG8_SA
#undef PG8_SB
#undef PG8_STAGE
#undef PG8_LDA
#undef PG8_LDB
#undef PG8_MMA
#undef PG8_WAIT_V
#undef PG8_WAIT_L
#undef PG8_BAR
#undef PG8_SCHED
}
}
namespace pg8 {
__device__ __forceinline__ float sigm(float x) { return __builtin_amdgcn_rcpf(1.0f + __expf(-x)); }
__device__ __forceinline__ float gelu_tanh(float x) { return x * sigm(1.5957691216f * (x + 0.044715f * x * x * x)); }

__device__ __forceinline__ float row_rinv(const float* ssq, int row) {
    const f32x4* p = (const f32x4*)(ssq + (size_t)row * 16); const f32x4 a = p[0], b = p[1], c = p[2], d = p[3];
    const float s = (((a[0] + a[1]) + (a[2] + a[3])) + ((b[0] + b[1]) + (b[2] + b[3]))) + (((c[0] + c[1]) + (c[2] + c[3])) + ((d[0] + d[1]) + (d[2] + d[3])));
    return rsqrtf(s * (1.0f / 1024.0f) + 1e-6f);
}
constexpr int RINV_LDS_OFF = 131072 + 2048;
struct RowRinv8 {
    float r[2][4];
    __device__ __forceinline__ void load(const float* ssq, int row0, int fq, int pm, PG8_LAS unsigned char* lds) {
        PG8_LAS f32x4* slot = (PG8_LAS f32x4*)(lds + RINV_LDS_OFF + (int)threadIdx.x * 48);
        const f32x4 t = slot[2];
        if (__float_as_int(t[0]) == pm + 1) { const f32x4 a = slot[0], b = slot[1]; r[0][0] = a[0]; r[0][1] = a[1]; r[0][2] = a[2]; r[0][3] = a[3]; r[1][0] = b[0]; r[1][1] = b[1]; r[1][2] = b[2]; r[1][3] = b[3]; }
        else {
            f32x4 p[2][4];
#pragma unroll
            for (int ai = 0; ai < 2; ++ai)
#pragma unroll
                for (int m = 0; m < 4; ++m) p[ai][m] = *(const f32x4*)(ssq + (size_t)(row0 + ai * HALF + m * 16) * 16 + 4 * fq);
#pragma unroll
            for (int ai = 0; ai < 2; ++ai)
#pragma unroll
                for (int m = 0; m < 4; ++m) { float s = (p[ai][m][0] + p[ai][m][1]) + (p[ai][m][2] + p[ai][m][3]); s += __shfl_xor(s, 16); s += __shfl_xor(s, 32); r[ai][m] = rsqrtf(s * (1.0f / 1024.0f) + 1e-6f); }
            slot[0] = (f32x4){r[0][0], r[0][1], r[0][2], r[0][3]}; slot[1] = (f32x4){r[1][0], r[1][1], r[1][2], r[1][3]}; slot[2] = (f32x4){__int_as_float(pm + 1), 0.f, 0.f, 0.f};
        }
    }
    __device__ __forceinline__ float get(int ai, int m) const { return r[ai][m]; }
};
struct EpiSwiGLU {
    static constexpr bool PERM = true, AFTER_DRAIN = false;
    bf16_t* O; int ldc; const float* ssq; PG8_LAS unsigned char* lds;
    __device__ __forceinline__ void operator()(const f32x4 (&acc)[2][2][4][2], const Unit& u, int wr, int wc, int fr, int fq) const {
        const int row0 = u.pm * BM + wr * 64 + fr, col0 = u.pn * HALF + wc * 32 + 8 * fq;
        RowRinv8 rr; rr.load(ssq, row0, fq, u.pm, lds);
#pragma unroll
        for (int ai = 0; ai < 2; ++ai)
#pragma unroll
            for (int m = 0; m < 4; ++m) {
                bf16_t* rowp = O + (size_t)(row0 + ai * HALF + m * 16) * ldc + col0;
                const float ri = rr.get(ai, m);
                float r[8];
#pragma unroll
                for (int n = 0; n < 2; ++n)
#pragma unroll
                    for (int j = 0; j < 4; ++j) { const float g = acc[ai][0][m][n][j] * ri, up = acc[ai][1][m][n][j] * ri; r[n * 4 + j] = g * sigm(g) * up; }
                u32x4 w; w.x = cvt_pk_bf16(r[0], r[1]); w.y = cvt_pk_bf16(r[2], r[3]); w.z = cvt_pk_bf16(r[4], r[5]); w.w = cvt_pk_bf16(r[6], r[7]);
                __builtin_nontemporal_store(w, (u32x4*)rowp);
            }
    }
};

struct EpiResid {
    static constexpr bool PERM = false, AFTER_DRAIN = false;
    const float* base32; float* out32; bf16_t* xb; float* ssq; int ldc; float scale;
    typedef unsigned u32x2_ __attribute__((ext_vector_type(2)));
    static __device__ __forceinline__ f32x4 unpack4(u32x2_ t) { return (f32x4){__uint_as_float(t.x << 16), __uint_as_float(t.x & 0xffff0000u), __uint_as_float(t.y << 16), __uint_as_float(t.y & 0xffff0000u)}; }
    __device__ __forceinline__ void operator()(const f32x4 (&acc)[2][2][4][2], const Unit& u, int wr, int wc, int fr, int fq) const {
        const int row0 = u.pm * BM + wr * 64 + fr, col0 = u.pn * BM + wc * 32 + 4 * fq;
        if (base32) {
#pragma unroll
            for (int ai = 0; ai < 2; ++ai)
#pragma unroll
                for (int m = 0; m < 4; ++m) {
                    const int row = row0 + ai * HALF + m * 16; const size_t off = (size_t)row * ldc + col0; float ss = 0.f;
#pragma unroll
                    for (int bj = 0; bj < 2; ++bj)
#pragma unroll
                        for (int n = 0; n < 2; ++n) { const size_t o = off + bj * HALF + n * 16; const f32x4 b = *(const f32x4*)(base32 + o);
                            f32x4 v = b + acc[ai][bj][m][n] * scale;
                            u32x2_ w; w.x = cvt_pk_bf16(v[0], v[1]); w.y = cvt_pk_bf16(v[2], v[3]); *(u32x2_*)(xb + o) = w;
                            if (out32) *(f32x4*)(out32 + o) = v; else v = unpack4(w);
                            ss += (v[0] * v[0] + v[1] * v[1]) + (v[2] * v[2] + v[3] * v[3]); }
                    ss += __shfl_xor(ss, 16); ss += __shfl_xor(ss, 32);
                    if (fq == 0) ssq[(size_t)row * 16 + 4 * u.pn + wc] = ss;
                    if (m & 1) asm volatile("" ::: "memory");
                }
        } else {
#pragma unroll
            for (int ai = 0; ai < 2; ++ai) {
                u32x2_ bb[4][2][2];
#pragma unroll
                for (int m = 0; m < 4; ++m)
#pragma unroll
                    for (int bj = 0; bj < 2; ++bj)
#pragma unroll
                        for (int n = 0; n < 2; ++n) bb[m][bj][n] = *(const u32x2_*)(xb + (size_t)(row0 + ai * HALF + m * 16) * ldc + col0 + bj * HALF + n * 16);
#pragma unroll
                for (int m = 0; m < 4; ++m) {
                    const int row = row0 + ai * HALF + m * 16; const size_t off = (size_t)row * ldc + col0; float ss = 0.f;
#pragma unroll
                    for (int bj = 0; bj < 2; ++bj)
#pragma unroll
                        for (int n = 0; n < 2; ++n) { const size_t o = off + bj * HALF + n * 16;
                            f32x4 v = unpack4(bb[m][bj][n]) + acc[ai][bj][m][n] * scale;
                            u32x2_ w; w.x = cvt_pk_bf16(v[0], v[1]); w.y = cvt_pk_bf16(v[2], v[3]); *(u32x2_*)(xb + o) = w;
                            if (out32) *(f32x4*)(out32 + o) = v; else v = unpack4(w);
                            ss += (v[0] * v[0] + v[1] * v[1]) + (v[2] * v[2] + v[3] * v[3]); }
                    ss += __shfl_xor(ss, 16); ss += __shfl_xor(ss, 32);
                    if (fq == 0) ssq[(size_t)row * 16 + 4 * u.pn + wc] = ss;
                }
                asm volatile("" ::: "memory");
            }
        }
    }
};

struct EpiMix {
    static constexpr bool PERM = true, AFTER_DRAIN = false;
    unsigned char* R; const float* lb; const float* ssq; PG8_LAS unsigned char* lds;
    __device__ __forceinline__ void operator()(const f32x4 (&acc)[2][2][4][2], const Unit& u, int wr, int wc, int fr, int fq) const {
        const int seg = u.pn >> 1;
        const int colb = (u.pn & 1) * 256 + wc * 32 + 8 * fq, row0 = u.pm * BM + wr * 64 + fr;
        RowRinv8 rr; rr.load(ssq, row0, fq, u.pm, lds);
        if (seg <= 1) {
            float* LF = (float*)(R + (seg == 0 ? (size_t)0 : ((size_t)64 << 20)));
#pragma unroll
            for (int bj = 0; bj < 2; ++bj) {
#pragma unroll
                for (int ai = 0; ai < 2; ++ai)
#pragma unroll
                    for (int m = 0; m < 4; ++m) {
                        float* rowp = LF + (size_t)(row0 + ai * HALF + m * 16) * 512 + colb + bj * HALF;
                        const float ri = rr.get(ai, m);
                        f32x4 o0, o1;
                        o0 = acc[ai][bj][m][0] * ri; o1 = acc[ai][bj][m][1] * ri;
                        __builtin_nontemporal_store(o0, (f32x4*)rowp); __builtin_nontemporal_store(o1, (f32x4*)(rowp + 4));
                    }
            }
        } else {
            const size_t boff = (size_t)(64 + 32 * seg) << 20;
            bf16_t* B = (bf16_t*)(R + boff);
#pragma unroll
            for (int ai = 0; ai < 2; ++ai)
#pragma unroll
                for (int m = 0; m < 4; ++m) {
                    const float ri = rr.get(ai, m);
#pragma unroll
                    for (int bj = 0; bj < 2; ++bj) {
                        bf16_t* rowp = B + (size_t)(row0 + ai * HALF + m * 16) * 512 + colb + bj * HALF;
                        float r[8];
#pragma unroll
                        for (int n = 0; n < 2; ++n)
#pragma unroll
                            for (int j = 0; j < 4; ++j) { const float x = acc[ai][bj][m][n][j] * ri; r[n * 4 + j] = x; }
                        u32x4 w; w.x = cvt_pk_bf16(r[0], r[1]); w.y = cvt_pk_bf16(r[2], r[3]); w.z = cvt_pk_bf16(r[4], r[5]); w.w = cvt_pk_bf16(r[6], r[7]);
                        __builtin_nontemporal_store(w, (u32x4*)rowp);
                    } }
        }
    }
};
}
constexpr int NB = 4, SEQ = 8192, D = 1024, FF = 2816, DIN = 3072, AW = 512, NLAYER = 2;
constexpr int M = NB * SEQ;
constexpr float EPS = 1e-6f;
#define LAS __attribute__((address_space(3)))
typedef pg8::bf16_t bf16_t;
typedef float f32x4 __attribute__((ext_vector_type(4)));
typedef float f32x2 __attribute__((ext_vector_type(2)));
typedef unsigned u32x4 __attribute__((ext_vector_type(4)));
typedef unsigned u32x2 __attribute__((ext_vector_type(2)));
constexpr size_t MiB = 1u << 20;
constexpr size_t WL_GU1 = 0, WL_DN1 = 11 * MiB, WL_WIN = WL_DN1 + 11 * MiB / 2, WL_WOUT = WL_WIN + 6 * MiB, WL_GU2 = WL_WOUT + 2 * MiB, WL_DN2 = WL_GU2 + 11 * MiB, WL_STRIDE = 41 * MiB;
static_assert(WL_DN2 + 11 * MiB / 2 == WL_STRIDE, "weights");
constexpr size_t WS_BAR = 82 * MiB + 65536, BAR_BYTES = 16384;
constexpr size_t WS_LBS = 82 * MiB, WS_DBUF = 83 * MiB, WS_SSQ = 84 * MiB;
constexpr size_t WS_XB = 86 * MiB;
constexpr size_t WS_R = 150 * MiB;
constexpr size_t R_Q = 0, R_LF = 64 * MiB, R_V = 128 * MiB, R_G = 160 * MiB, R_U = 192 * MiB, R_VV = 224 * MiB, R_O = 256 * MiB;
constexpr size_t WS_END = WS_R + R_O + 64 * MiB;
constexpr int LDS_BYTES = 131072 + 2048 + 512 * 48;

__device__ __forceinline__ float bf2f(unsigned h) { return __uint_as_float(h << 16); }
__device__ __forceinline__ float wave_sum(float v) {
#pragma unroll
    for (int o = 1; o < 64; o <<= 1) v += __shfl_xor(v, o);
    return v;
}
#define LDS_WAIT() asm volatile("s_waitcnt lgkmcnt(0)" ::: "memory")

__device__ __forceinline__ void transpose_item(const float* W, int K, int N, bf16_t* WT, int k0, int n0, int drow0, const float* gain, LAS float* scr, int lane) {
    f32x4 v[8]; float gk[8];
#pragma unroll
    for (int i = 0; i < 8; ++i) { const int kk = 8 * i + (lane >> 3); v[i] = *(const f32x4*)(W + (size_t)(k0 + kk) * N + n0 + (lane & 7) * 4); gk[i] = gain ? gain[k0 + kk] : 1.0f; }
#pragma unroll
    for (int i = 0; i < 8; ++i) { const int kk = 8 * i + (lane >> 3); LAS float* d = scr + kk * 33 + (lane & 7) * 4; d[0] = v[i][0] * gk[i]; d[1] = v[i][1] * gk[i]; d[2] = v[i][2] * gk[i]; d[3] = v[i][3] * gk[i]; }
    LDS_WAIT(); asm volatile("" ::: "memory");
    const int c = lane & 7;
#pragma unroll
    for (int j = 0; j < 4; ++j) { const int n = (lane >> 3) + 8 * j; const LAS float* s = scr + (8 * c) * 33 + n;
        u32x4 o; o.x = pg8::cvt_pk_bf16(s[0 * 33], s[1 * 33]); o.y = pg8::cvt_pk_bf16(s[2 * 33], s[3 * 33]); o.z = pg8::cvt_pk_bf16(s[4 * 33], s[5 * 33]); o.w = pg8::cvt_pk_bf16(s[6 * 33], s[7 * 33]);
        *(u32x4*)(WT + (size_t)(drow0 + n) * K + k0 + 8 * c) = o; }
    LDS_WAIT(); asm volatile("" ::: "memory");
}

__device__ __forceinline__ void row_to_xb(const float* xrow, bf16_t* orow, float* ssqrow, int lane) {
    const f32x4* xr = (const f32x4*)xrow + lane;
    f32x4 v[4]; float s = 0.f;
#pragma unroll
    for (int j = 0; j < 4; ++j) { v[j] = xr[64 * j]; s += (v[j].x * v[j].x + v[j].y * v[j].y) + (v[j].z * v[j].z + v[j].w * v[j].w); }
    s = wave_sum(s);
    u32x2* o8 = (u32x2*)orow + lane;
#pragma unroll
    for (int j = 0; j < 4; ++j) { u32x2 o; o.x = pg8::cvt_pk_bf16(v[j].x, v[j].y); o.y = pg8::cvt_pk_bf16(v[j].z, v[j].w); o8[64 * j] = o; }
    if (lane < 4) ((f32x4*)ssqrow)[lane] = (f32x4){lane == 0 ? s : 0.f, 0.f, 0.f, 0.f};
}
__device__ __forceinline__ void final_norm_row(const bf16_t* xrow, float* orow, const float* g, const float* ssq, int row, int lane) {
    const float rinv = pg8::row_rinv(ssq, row);
    const u32x2* xr = (const u32x2*)xrow + lane; const f32x4* gr = (const f32x4*)g + lane; f32x4* o = (f32x4*)orow + lane;
    u32x2 v[4];
#pragma unroll
    for (int j = 0; j < 4; ++j) v[j] = xr[64 * j];
#pragma unroll
    for (int j = 0; j < 4; ++j) { const f32x4 x = (f32x4){bf2f(v[j].x & 0xffff), bf2f(v[j].x >> 16), bf2f(v[j].y & 0xffff), bf2f(v[j].y >> 16)}; o[64 * j] = x * rinv * gr[64 * j]; }
}

#define XB_TMO      128
#define XB_XCNT(j)  (256  + 64 * (j))
#define XB_XSUB(j)  (1280 + 64 * (j))
#define XB_XGEN(j)  (2304 + 64 * (j))
#define XB_TOP      3328
#define XB_TOPGEN   3392
#define XCD_BAR_WORDS 3456
#define XB_SPIN_CAP (1u << 18)

__device__ __forceinline__ unsigned xb_ld(unsigned* p)              { return __hip_atomic_load(p, __ATOMIC_RELAXED, __HIP_MEMORY_SCOPE_AGENT); }
__device__ __forceinline__ unsigned xb_add(unsigned* p, unsigned v) { return __hip_atomic_fetch_add(p, v, __ATOMIC_RELAXED, __HIP_MEMORY_SCOPE_AGENT); }
__device__ __forceinline__ unsigned xb_xcc_id() { return (unsigned)__builtin_amdgcn_s_getreg((3 << 11) | 20) & 0xFu; }
#define XB_SPIN(cond, bar) do { unsigned _sp = 0; while (cond) { __builtin_amdgcn_s_sleep(1); \
    if ((++_sp & 255u) == 0u) { if (xb_ld(&(bar)[XB_TMO])) break; if (_sp > XB_SPIN_CAP) { atomicAdd(&(bar)[XB_TMO], 1u); break; } } } } while (0)

struct XcdBarrier {
    unsigned* bar; unsigned x;
    volatile LAS unsigned* st;
};

__device__ __forceinline__ XcdBarrier xcd_barrier_post(unsigned* bar, volatile LAS unsigned* st) {
    XcdBarrier b; b.bar = bar; b.x = xb_xcc_id(); b.st = st;
    if (threadIdx.x == 0) (void)xb_add(&bar[XB_XCNT(b.x)], 1u);
    return b;
}
__device__ __forceinline__ void xcd_barrier_complete(unsigned* bar, unsigned x, unsigned& nloc, unsigned& nx) {
    const unsigned G = gridDim.x * gridDim.y * gridDim.z;
    unsigned sum, cnt, mine, sp = 0u;
    for (;;) {
        sum = 0u; cnt = 0u; mine = 0u;
#pragma unroll
        for (unsigned j = 0; j < 16; ++j) { const unsigned c = xb_ld(&bar[XB_XCNT(j)]); sum += c; cnt += (c > 0u) ? 1u : 0u; mine = (j == x) ? c : mine; }
        if (sum == G) break;
        __builtin_amdgcn_s_sleep(1);
        if ((++sp & 255u) == 0u) { if (xb_ld(&bar[XB_TMO])) break; if (sp > XB_SPIN_CAP) { atomicAdd(&bar[XB_TMO], 1u); break; } }
    }
    nloc = mine > 0u ? mine : 1u; nx = cnt > 0u ? cnt : 1u;
}

__device__ __forceinline__ void xcd_barrier(const XcdBarrier& b) {
    asm volatile("s_waitcnt vmcnt(0)" ::: "memory");
    __syncthreads();
    if (threadIdx.x == 0) {
        unsigned* bar = b.bar;
        __builtin_amdgcn_s_waitcnt(0);
        unsigned nloc = b.st[0], nx = b.st[1];
        if (nloc == 0u) { xcd_barrier_complete(bar, b.x, nloc, nx); b.st[0] = nloc; b.st[1] = nx; }
        const unsigned old = xb_add(&bar[XB_XSUB(b.x)], 1u);
        const unsigned gen = old / nloc;
        if (old + 1u == (gen + 1u) * nloc) {
            __builtin_amdgcn_fence(__ATOMIC_RELEASE, "agent");
            asm volatile("s_waitcnt vmcnt(0)" ::: "memory");
            const unsigned og = xb_add(&bar[XB_TOP], 1u);
            const unsigned tg = og / nx;
            if (og + 1u == (tg + 1u) * nx) xb_add(&bar[XB_TOPGEN], 1u);
            else XB_SPIN(xb_ld(&bar[XB_TOPGEN]) == tg, bar);
            __builtin_amdgcn_fence(__ATOMIC_ACQUIRE, "agent");
            xb_add(&bar[XB_XGEN(b.x)], 1u);
            asm volatile("s_waitcnt vmcnt(0)" ::: "memory");
        } else {
            XB_SPIN(xb_ld(&bar[XB_XGEN(b.x)]) == gen, bar);
            __builtin_amdgcn_fence(__ATOMIC_ACQUIRE, "agent");
            asm volatile("s_waitcnt vmcnt(0)" ::: "memory");
        }
    }
    __syncthreads();
}

#ifndef PROBE_PREP
#define PROBE_PREP 0
#endif
#ifndef PROBE_SYNCS
#define PROBE_SYNCS 0
#endif
#ifdef PROBE_DUP_S
constexpr int NPHASE = 2 + PROBE_PREP + PROBE_SYNCS + 10 * NLAYER;
#else
constexpr int NPHASE = 2 + PROBE_PREP + PROBE_SYNCS + 9 * NLAYER;
#endif
struct Params { const float* in[19]; float* out; unsigned char* ws; int ph_lo, ph_hi; };
typedef const __attribute__((address_space(4))) unsigned long long* kaptr_t;
__device__ __forceinline__ unsigned long long karg(int i) { kaptr_t ka = (kaptr_t)__builtin_amdgcn_kernarg_segment_ptr(); asm volatile("" : "+s"(ka)); return ka[i]; }
__device__ __forceinline__ const float* kin(int i) { return (const float*)karg(i); }
__device__ __forceinline__ float* kout() { return (float*)karg(19); }
__device__ __forceinline__ unsigned char* kws() { return (unsigned char*)karg(20); }


typedef short bf16x8 __attribute__((ext_vector_type(8)));
#define MFMA16(a, b, c) __builtin_amdgcn_mfma_f32_16x16x32_bf16(a, b, c, 0, 0, 0)
typedef __bf16 bf16v2_t __attribute__((ext_vector_type(2)));
__device__ __forceinline__ unsigned cvt2(float lo, float hi) { bf16v2_t r = __builtin_convertvector((f32x2){lo, hi}, bf16v2_t); return __builtin_bit_cast(unsigned, r); }
#define LDFRAG(base, row, stride_b, kofs) (*(const LAS bf16x8*)((base) + (row) * (stride_b) + (kofs) * 2))
constexpr int KT_STRIDE = 144;
constexpr int QK_STRIDE = 272;

__device__ __forceinline__ float sigm_(float x) { return __builtin_amdgcn_rcpf(1.0f + __expf(-x)); }
__device__ __forceinline__ float gelu_(float x) { return x * sigm_(1.5957691216f * (x + 0.044715f * x * x * x)); }
#define HG_CUMSUM(LFp, tot) \
    float lf[16], a[16]; { const float* lfp = (LFp) + (size_t)(r0 + seg * 16) * AW + h * 128 + k; \
    _Pragma("unroll") for (int i = 0; i < 16; ++i) lf[i] = lfp[(size_t)i * AW]; \
    { const float lb_ = lbp[h * 128 + k]; _Pragma("unroll") for (int i = 0; i < 16; ++i) lf[i] = __logf(fmaxf(lb_ + (1.0f - lb_) * sigm_(lf[i]), 1e-20f)); } \
    float c = 0.f; _Pragma("unroll") for (int i = 0; i < 16; ++i) { c += lf[i]; a[i] = c; } \
    (tot)[seg * 128 + k] = c; } \
    __syncthreads(); \
    const float t0_ = (tot)[k], t1_ = (tot)[128 + k], t2_ = (tot)[256 + k], t3_ = (tot)[384 + k]; \
    const float pre_ = seg == 0 ? 0.f : (seg == 1 ? t0_ : (seg == 2 ? t0_ + t1_ : t0_ + t1_ + t2_)); \
    const float a_last = (t0_ + t1_) + (t2_ + t3_), a_ref = t0_ + t1_; \
    _Pragma("unroll") for (int i = 0; i < 16; ++i) a[i] += pre_;

__device__ __forceinline__ void load_v(u32x4 (&w)[2], const bf16_t* Vp, int tid) {
#pragma unroll
    for (int i = 0; i < 2; ++i) { const int idx = tid + 512 * i, s = idx & 63, vc = idx >> 6; w[i] = *(const u32x4*)(Vp + (size_t)s * AW + vc * 8); }
}
__device__ __forceinline__ void store_vt(LAS unsigned char* vt, const u32x4 (&w)[2], int tid) {
#pragma unroll
    for (int i = 0; i < 2; ++i) { const int idx = tid + 512 * i, s = idx & 63, vc = idx >> 6;
        LAS unsigned short* d = (LAS unsigned short*)(vt + (vc * 8) * KT_STRIDE + s * 2);
        d[0 * (KT_STRIDE / 2)] = (unsigned short)(w[i].x & 0xffff); d[1 * (KT_STRIDE / 2)] = (unsigned short)(w[i].x >> 16);
        d[2 * (KT_STRIDE / 2)] = (unsigned short)(w[i].y & 0xffff); d[3 * (KT_STRIDE / 2)] = (unsigned short)(w[i].y >> 16);
        d[4 * (KT_STRIDE / 2)] = (unsigned short)(w[i].z & 0xffff); d[5 * (KT_STRIDE / 2)] = (unsigned short)(w[i].z >> 16);
        d[6 * (KT_STRIDE / 2)] = (unsigned short)(w[i].w & 0xffff); d[7 * (KT_STRIDE / 2)] = (unsigned short)(w[i].w >> 16); }
}

__device__ __forceinline__ void hgrn_pass1(LAS unsigned char* lds, const unsigned char* R, bf16_t* ST, float* DBUF, const float* lbp, int unit, int tid) {
    const int bh = unit >> 7, n = unit & 127, b = bh >> 2, h = bh & 3; const size_t r0 = (size_t)b * SEQ + n * 64;
    const int k = tid & 127, seg = tid >> 7, lane = tid & 63, w = __builtin_amdgcn_readfirstlane(tid >> 6), fr = lane & 15, fq = lane >> 4;
    LAS unsigned char* kdt = lds; LAS unsigned char* vt = lds + 18432; LAS float* tot = (LAS float*)(lds + 36864);
    const float* LF = (const float*)(R + R_LF); const bf16_t* V = (const bf16_t*)(R + R_V);
    u32x4 vw[2]; load_v(vw, V + r0 * AW + h * 128, tid);
    __syncthreads();
    HG_CUMSUM(LF, tot)
    {   unsigned pk[8];
#pragma unroll
        for (int i = 0; i < 8; ++i) { const float k0 = (1.0f - __expf(lf[2 * i])) * __expf(a_last - a[2 * i]), k1 = (1.0f - __expf(lf[2 * i + 1])) * __expf(a_last - a[2 * i + 1]); pk[i] = cvt2(k0, k1); }
        LAS u32x4* d = (LAS u32x4*)(kdt + k * KT_STRIDE + seg * 32);
        d[0] = (u32x4){pk[0], pk[1], pk[2], pk[3]}; d[1] = (u32x4){pk[4], pk[5], pk[6], pk[7]};
        if (seg == 0) DBUF[(size_t)unit * 128 + k] = __expf(a_last); }
    store_vt(vt, vw, tid);
    __syncthreads();
    bf16x8 bV[2];
#pragma unroll
    for (int ks = 0; ks < 2; ++ks) bV[ks] = LDFRAG(vt, 16 * w + fr, KT_STRIDE, 32 * ks + 8 * fq);
    bf16_t* up = ST + (size_t)unit * 16384 + (size_t)(16 * w + fr) * 128 + 4 * fq;
#pragma unroll
    for (int kt = 0; kt < 8; ++kt) { f32x4 acc = (f32x4){0.f, 0.f, 0.f, 0.f};
#pragma unroll
        for (int ks = 0; ks < 2; ++ks) acc = MFMA16(LDFRAG(kdt, 16 * kt + fr, KT_STRIDE, 32 * ks + 8 * fq), bV[ks], acc);
        u32x2 o; o.x = cvt2(acc[0], acc[1]); o.y = cvt2(acc[2], acc[3]);
        *(u32x2*)(up + 16 * kt) = o; }
}

__device__ __forceinline__ void hgrn_scan(unsigned* STw, const float* DBUF, int item, int tid) {
    const int bh = item >> 4, e2 = (item & 15) * 512 + tid;
    unsigned* Up = STw + (size_t)bh * 128 * 8192 + e2;
    const float* dp = DBUF + (size_t)bh * 128 * 128 + ((2 * e2) & 127);
    float S0 = 0.f, S1 = 0.f;
    for (int n0 = 0; n0 < 128; n0 += 16) {
        unsigned u[16]; f32x2 d[16];
#pragma unroll
        for (int i = 0; i < 16; ++i) { u[i] = Up[(size_t)(n0 + i) * 8192]; d[i] = *(const f32x2*)(dp + (n0 + i) * 128); }
#pragma unroll
        for (int i = 0; i < 16; ++i) { Up[(size_t)(n0 + i) * 8192] = cvt2(S0, S1); S0 = d[i].x * S0 + bf2f(u[i] & 0xffff); S1 = d[i].y * S1 + bf2f(u[i] >> 16); }
    }
}

__device__ __forceinline__ unsigned bf_hi(float x) { return cvt2(x, 0.f) & 0xffffu; }
__device__ __forceinline__ void hgrn_pass3(LAS unsigned char* lds, const unsigned char* R, const bf16_t* ST, bf16_t* O, const float* ng, const float* lbp, int unit, int tid) {
    const int bh = unit >> 7, n = unit & 127, b = bh >> 2, h = bh & 3; const size_t r0 = (size_t)b * SEQ + n * 64;
    const int k = tid & 127, seg = tid >> 7, lane = tid & 63, w = __builtin_amdgcn_readfirstlane(tid >> 6), fr = lane & 15, fq = lane >> 4;
    LAS unsigned char* qmh = lds; LAS unsigned char* qml = lds + 17408; LAS unsigned char* kmh = lds + 34816; LAS unsigned char* kml = lds + 52224; LAS unsigned char* qs = lds + 69632;
    LAS unsigned char* vt = lds + 87040; LAS unsigned char* pp = lds + 105472; LAS float* tot = (LAS float*)(lds + 114688); LAS float* red = (LAS float*)(lds + 116736);
    const float* Q = (const float*)(R + R_Q); const float* LF = (const float*)(R + R_LF); const bf16_t* V = (const bf16_t*)(R + R_V); const bf16_t* GB = (const bf16_t*)(R + R_G);
    const int tt = w & 3, vh = w >> 2;
    bf16x8 aS[4][4];
    { const bf16_t* sp = ST + (size_t)unit * 16384 + (size_t)(64 * vh + fr) * 128 + 8 * fq;
#pragma unroll
      for (int j = 0; j < 4; ++j)
#pragma unroll
        for (int ks = 0; ks < 4; ++ks) aS[j][ks] = *(const bf16x8*)(sp + (size_t)(16 * j) * 128 + 32 * ks); }
    u32x4 vw[2]; load_v(vw, V + r0 * AW + h * 128, tid);
    u32x2 ggv[4]; f32x4 g4v[4];
#pragma unroll
    for (int j = 0; j < 4; ++j) { const int v0 = 16 * (4 * vh + j) + 4 * fq; ggv[j] = *(const u32x2*)(GB + (r0 + 16 * tt + fr) * AW + h * 128 + v0); g4v[j] = *(const f32x4*)(ng + h * 128 + v0); }
    __syncthreads();
    float qv[16];
    { const float* qp = Q + (size_t)(r0 + seg * 16) * AW + h * 128 + k;
#pragma unroll
      for (int i = 0; i < 16; ++i) qv[i] = qp[(size_t)i * AW]; }
    HG_CUMSUM(LF, tot)
#pragma unroll
    for (int i = 0; i < 16; ++i) { const int t = seg * 16 + i; const float kk = 1.0f - __expf(lf[i]);
        const float qmv = qv[i] * __expf(a[i] - a_ref), kmv = kk * __expf(a_ref - a[i]);
        const unsigned qh = bf_hi(qmv), kh = bf_hi(kmv);
        *(LAS unsigned short*)(qmh + t * QK_STRIDE + k * 2) = (unsigned short)qh;
        *(LAS unsigned short*)(qml + t * QK_STRIDE + k * 2) = (unsigned short)bf_hi(qmv - bf2f(qh));
        *(LAS unsigned short*)(kmh + t * QK_STRIDE + k * 2) = (unsigned short)kh;
        *(LAS unsigned short*)(kml + t * QK_STRIDE + k * 2) = (unsigned short)bf_hi(kmv - bf2f(kh));
        *(LAS unsigned short*)(qs + t * QK_STRIDE + k * 2) = (unsigned short)bf_hi(qv[i] * __expf(a[i])); }
    store_vt(vt, vw, tid);
    __syncthreads();
#pragma unroll
    for (int i2 = 0; i2 < 2; ++i2) { const int st = 2 * vh + i2; f32x4 acc = (f32x4){0.f, 0.f, 0.f, 0.f};
        if (st <= tt) {
#pragma unroll
            for (int ks = 0; ks < 4; ++ks) { const bf16x8 kH = LDFRAG(kmh, 16 * st + fr, QK_STRIDE, 32 * ks + 8 * fq), kL = LDFRAG(kml, 16 * st + fr, QK_STRIDE, 32 * ks + 8 * fq);
                const bf16x8 qH = LDFRAG(qmh, 16 * tt + fr, QK_STRIDE, 32 * ks + 8 * fq), qL = LDFRAG(qml, 16 * tt + fr, QK_STRIDE, 32 * ks + 8 * fq);
                acc = MFMA16(kL, qH, acc); acc = MFMA16(kH, qL, acc); acc = MFMA16(kH, qH, acc); }
            const int t = 16 * tt + fr, s0 = 16 * st + 4 * fq;
#pragma unroll
            for (int e = 0; e < 4; ++e) acc[e] = (s0 + e <= t) ? acc[e] : 0.f; }
        u32x2 o; o.x = cvt2(acc[0], acc[1]); o.y = cvt2(acc[2], acc[3]);
        *(LAS u32x2*)(pp + (16 * tt + fr) * KT_STRIDE + (16 * st + 4 * fq) * 2) = o; }
    __syncthreads();
    f32x4 o4[4];
    { bf16x8 bP[2], bQ[4];
#pragma unroll
      for (int ks = 0; ks < 2; ++ks) bP[ks] = LDFRAG(pp, 16 * tt + fr, KT_STRIDE, 32 * ks + 8 * fq);
#pragma unroll
      for (int ks = 0; ks < 4; ++ks) bQ[ks] = LDFRAG(qs, 16 * tt + fr, QK_STRIDE, 32 * ks + 8 * fq);
#pragma unroll
      for (int j = 0; j < 4; ++j) { f32x4 acc = (f32x4){0.f, 0.f, 0.f, 0.f};
#pragma unroll
        for (int ks = 0; ks < 2; ++ks) acc = MFMA16(LDFRAG(vt, 16 * (4 * vh + j) + fr, KT_STRIDE, 32 * ks + 8 * fq), bP[ks], acc);
#pragma unroll
        for (int ks = 0; ks < 4; ++ks) acc = MFMA16(aS[j][ks], bQ[ks], acc);
        o4[j] = acc; } }
    float ss = 0.f;
#pragma unroll
    for (int j = 0; j < 4; ++j) ss += (o4[j][0] * o4[j][0] + o4[j][1] * o4[j][1]) + (o4[j][2] * o4[j][2] + o4[j][3] * o4[j][3]);
    ss += __shfl_xor(ss, 16); ss += __shfl_xor(ss, 32);
    if (fq == 0) red[vh * 64 + 16 * tt + fr] = ss;
    __syncthreads();
    const float rinv = rsqrtf((red[16 * tt + fr] + red[64 + 16 * tt + fr]) * (1.f / 128.f) + EPS);
    const size_t row = r0 + 16 * tt + fr;
#pragma unroll
    for (int j = 0; j < 4; ++j) { const int v0 = 16 * (4 * vh + j) + 4 * fq;
        const f32x4 g4 = g4v[j]; const u32x2 gg = ggv[j];
        const float s0 = bf2f(gg.x & 0xffff), s1 = bf2f(gg.x >> 16), s2 = bf2f(gg.y & 0xffff), s3 = bf2f(gg.y >> 16);
        u32x2 o; o.x = cvt2(o4[j][0] * rinv * g4[0] * (s0 * sigm_(s0)), o4[j][1] * rinv * g4[1] * (s1 * sigm_(s1)));
        o.y = cvt2(o4[j][2] * rinv * g4[2] * (s2 * sigm_(s2)), o4[j][3] * rinv * g4[3] * (s3 * sigm_(s3)));
        *(u32x2*)(O + row * D + h * 128 + v0) = o; }
}

__device__ __forceinline__ void gmlp_mfma(LAS unsigned char* lds, const unsigned char* R, bf16_t* O, const float* lng, const float* lnb, const float* wsp, const float* bsp, int unit, int tid) {
    const int lane = tid & 63, w = __builtin_amdgcn_readfirstlane(tid >> 6), fr = lane & 15, fq = lane >> 4;
    const size_t r0 = (size_t)unit * 128;
    const bf16_t* U = (const bf16_t*)(R + R_U); const bf16_t* VV = (const bf16_t*)(R + R_VV);
    LAS unsigned char* vnt = lds; LAS unsigned char* wt = lds + 34816; LAS float* mu = (LAS float*)(lds + 69632); LAS float* rs = mu + 128;
    __syncthreads();
    for (int i = 0; i < 16; ++i) { const int t = w * 16 + i; const u32x4 x4 = *(const u32x4*)(VV + (r0 + t) * AW + lane * 8);
        float x[8]; x[0] = gelu_(bf2f(x4.x & 0xffff)); x[1] = gelu_(bf2f(x4.x >> 16)); x[2] = gelu_(bf2f(x4.y & 0xffff)); x[3] = gelu_(bf2f(x4.y >> 16)); x[4] = gelu_(bf2f(x4.z & 0xffff)); x[5] = gelu_(bf2f(x4.z >> 16)); x[6] = gelu_(bf2f(x4.w & 0xffff)); x[7] = gelu_(bf2f(x4.w >> 16));
        float s = 0.f;
#pragma unroll
        for (int j = 0; j < 8; ++j) s += x[j];
        const float mean = wave_sum(s) * (1.f / 512.f); float q = 0.f;
#pragma unroll
        for (int j = 0; j < 8; ++j) q += (x[j] - mean) * (x[j] - mean);
        const float rstd = rsqrtf(wave_sum(q) * (1.f / 512.f) + EPS);
        if (lane == 0) { mu[t] = mean; rs[t] = rstd; } }
    __syncthreads();
    for (int g = 0; g < 4; ++g) {
#pragma unroll
        for (int i = 0; i < 4; ++i) { const int idx = tid + 512 * i, s = idx & 127, ch = idx >> 7;
            const u32x4 x4 = *(const u32x4*)(VV + (r0 + s) * AW + g * 128 + ch * 8);
            const f32x4 ga = *(const f32x4*)(lng + g * 128 + ch * 8), gb = *(const f32x4*)(lng + g * 128 + ch * 8 + 4), ba = *(const f32x4*)(lnb + g * 128 + ch * 8), bb = *(const f32x4*)(lnb + g * 128 + ch * 8 + 4);
            const float m_ = mu[s], r_ = rs[s];
            LAS unsigned short* d = (LAS unsigned short*)(vnt + (ch * 8) * QK_STRIDE + s * 2);
            d[0 * (QK_STRIDE / 2)] = (unsigned short)(cvt2((gelu_(bf2f(x4.x & 0xffff)) - m_) * r_ * ga[0] + ba[0], 0.f) & 0xffff);
            d[1 * (QK_STRIDE / 2)] = (unsigned short)(cvt2((gelu_(bf2f(x4.x >> 16)) - m_) * r_ * ga[1] + ba[1], 0.f) & 0xffff);
            d[2 * (QK_STRIDE / 2)] = (unsigned short)(cvt2((gelu_(bf2f(x4.y & 0xffff)) - m_) * r_ * ga[2] + ba[2], 0.f) & 0xffff);
            d[3 * (QK_STRIDE / 2)] = (unsigned short)(cvt2((gelu_(bf2f(x4.y >> 16)) - m_) * r_ * ga[3] + ba[3], 0.f) & 0xffff);
            d[4 * (QK_STRIDE / 2)] = (unsigned short)(cvt2((gelu_(bf2f(x4.z & 0xffff)) - m_) * r_ * gb[0] + bb[0], 0.f) & 0xffff);
            d[5 * (QK_STRIDE / 2)] = (unsigned short)(cvt2((gelu_(bf2f(x4.z >> 16)) - m_) * r_ * gb[1] + bb[1], 0.f) & 0xffff);
            d[6 * (QK_STRIDE / 2)] = (unsigned short)(cvt2((gelu_(bf2f(x4.w & 0xffff)) - m_) * r_ * gb[2] + bb[2], 0.f) & 0xffff);
            d[7 * (QK_STRIDE / 2)] = (unsigned short)(cvt2((gelu_(bf2f(x4.w >> 16)) - m_) * r_ * gb[3] + bb[3], 0.f) & 0xffff); }
#pragma unroll
        for (int i = 0; i < 8; ++i) { const int idx = tid + 512 * i, t = idx >> 5, s0 = (idx & 31) * 4;
            const f32x4 x = *(const f32x4*)(wsp + (size_t)(g * 128 + t) * 128 + s0);
            u32x2 o; o.x = cvt2(s0 <= t ? x[0] : 0.f, s0 + 1 <= t ? x[1] : 0.f); o.y = cvt2(s0 + 2 <= t ? x[2] : 0.f, s0 + 3 <= t ? x[3] : 0.f);
            *(LAS u32x2*)(wt + t * QK_STRIDE + s0 * 2) = o; }
        __syncthreads();
        f32x4 acc[8];
#pragma unroll
        for (int ct = 0; ct < 8; ++ct) acc[ct] = (f32x4){0.f, 0.f, 0.f, 0.f};
        for (int ks = 0; ks <= (w >> 1); ++ks) { const bf16x8 bW = LDFRAG(wt, 16 * w + fr, QK_STRIDE, 32 * ks + 8 * fq);
#pragma unroll
            for (int ct = 0; ct < 8; ++ct) acc[ct] = MFMA16(LDFRAG(vnt, 16 * ct + fr, QK_STRIDE, 32 * ks + 8 * fq), bW, acc[ct]); }
        const int t = 16 * w + fr; const float bt = bsp[g * 128 + t];
#pragma unroll
        for (int ct = 0; ct < 8; ++ct) { const int c0 = g * 128 + 16 * ct + 4 * fq; const u32x2 uu = *(const u32x2*)(U + (r0 + t) * AW + c0);
            u32x2 o; o.x = cvt2(gelu_(bf2f(uu.x & 0xffff)) * (acc[ct][0] + bt), gelu_(bf2f(uu.x >> 16)) * (acc[ct][1] + bt));
            o.y = cvt2(gelu_(bf2f(uu.y & 0xffff)) * (acc[ct][2] + bt), gelu_(bf2f(uu.y >> 16)) * (acc[ct][3] + bt));
            *(u32x2*)(O + (r0 + t) * D + 512 + c0) = o; }
        __syncthreads();
    }
}
__global__ void __launch_bounds__(512, 2) mega(Params p) {
    extern __shared__ __attribute__((aligned(16))) unsigned char lds_raw[];
    LAS unsigned char* lds = (LAS unsigned char*)lds_raw;
    cg::grid_group grid = cg::this_grid();
    const int ph_lo = p.ph_lo, ph_hi = p.ph_hi;
    volatile LAS unsigned* bst = (volatile LAS unsigned*)(lds + 131072 + 1024);
    if (threadIdx.x == 0) { bst[0] = 0u; bst[1] = 0u; }
    __syncthreads();
    const XcdBarrier bar = xcd_barrier_post((unsigned*)(kws() + WS_BAR), bst);
    for (int ph = ph_lo; ph < ph_hi; ++ph) {
        if (ph > ph_lo) {
            if (ph_hi < 0) grid.sync();
            xcd_barrier(bar);
        }
        int tid_ = threadIdx.x; asm volatile("" : "+v"(tid_));
        const int tid = tid_, lane = tid & 63, wave = __builtin_amdgcn_readfirstlane(tid >> 6);
        const int G = gridDim.x, gw = blockIdx.x * 8 + wave, NGW = G * 8;
        unsigned char* ws = kws();
        float* X = kout();
        bf16_t* XB = (bf16_t*)(ws + WS_XB);
        float* SSQ = (float*)(ws + WS_SSQ);
        unsigned char* R = ws + WS_R;
        bf16_t* OB = (bf16_t*)(R + R_O);
        float* LBS = (float*)(ws + WS_LBS);
        if (ph <= PROBE_PREP) {
            LAS float* scr = (LAS float*)(lds + wave * 16384);
            constexpr int IG = 16 * 88, IDN = 44 * 32, IIN = 16 * 96, IOUT = 16 * 32, IL = 6 * IG + IIN + IOUT;
            static_assert(IG == IDN, "items");
            for (int it = gw; it < NLAYER * IL; it += NGW) {
                const int l = it / IL; int r = it % IL;
                unsigned char* wl = ws + (size_t)l * WL_STRIDE;
                const float* W; int K, N, mode = 0; bf16_t* WT; const float* gain = nullptr;
                if (r < IG) { W = kin(2) + (size_t)l * D * FF; K = D; N = FF; WT = (bf16_t*)(wl + WL_GU1); mode = 1; gain = kin(1) + l * D; }
                else if ((r -= IG) < IG) { W = kin(3) + (size_t)l * D * FF; K = D; N = FF; WT = (bf16_t*)(wl + WL_GU1); mode = 2; gain = kin(1) + l * D; }
                else if ((r -= IG) < IDN) { W = kin(4) + (size_t)l * D * FF; K = FF; N = D; WT = (bf16_t*)(wl + WL_DN1); }
                else if ((r -= IDN) < IIN) { W = kin(6) + (size_t)l * D * DIN; K = D; N = DIN; WT = (bf16_t*)(wl + WL_WIN); gain = kin(5) + l * D; }
                else if ((r -= IIN) < IOUT) { W = kin(13) + (size_t)l * D * D; K = D; N = D; WT = (bf16_t*)(wl + WL_WOUT); }
                else if ((r -= IOUT) < IG) { W = kin(15) + (size_t)l * D * FF; K = D; N = FF; WT = (bf16_t*)(wl + WL_GU2); mode = 1; gain = kin(14) + l * D; }
                else if ((r -= IG) < IG) { W = kin(16) + (size_t)l * D * FF; K = D; N = FF; WT = (bf16_t*)(wl + WL_GU2); mode = 2; gain = kin(14) + l * D; }
                else { r -= IG; W = kin(17) + (size_t)l * D * FF; K = FF; N = D; WT = (bf16_t*)(wl + WL_DN2); }
                const int nblk = N / 32, kb = r / nblk, nb = r % nblk, k0 = 64 * kb, n0 = 32 * nb;
                const int drow0 = mode == 0 ? n0 : ((n0 >> 7) * 256 + (n0 & 127) + (mode == 2 ? 128 : 0));
                transpose_item(W, K, N, WT, k0, n0, drow0, gain, scr, lane);
            }
            if (blockIdx.x == 0) { const float a0 = kin(7)[tid], a1 = kin(7)[AW + tid]; LBS[tid] = 0.f; LBS[AW + tid] = 1.0f / (1.0f + __expf(a0 - a1)); }
            for (int m = gw; m < M; m += NGW) row_to_xb(kin(0) + (size_t)m * D, XB + (size_t)m * D, SSQ + (size_t)m * 16, lane);
            continue;
        }
        if (ph >= NPHASE - 1 - PROBE_SYNCS && ph < NPHASE - 1) continue;
        if (ph == NPHASE - 1) {
            for (int m = gw; m < M; m += NGW) final_norm_row(XB + (size_t)m * D, X + (size_t)m * D, kin(18), SSQ, m, lane);
            continue;
        }
#ifdef PROBE_DUP_S
        const int q = ph - 1 - PROBE_PREP, l = q / 10, s0 = q % 10, s = s0 <= PROBE_DUP_S ? s0 : s0 - 1;
        if ((PROBE_DUP_S == 1 || PROBE_DUP_S == 6 || PROBE_DUP_S == 8) && s0 == PROBE_DUP_S + 1 && !(l == 0 && PROBE_DUP_S == 1)) continue;
#else
        const int q = ph - 1 - PROBE_PREP, l = q / 9, s = q % 9;
#endif
        unsigned char* wl = ws + (size_t)l * WL_STRIDE;
        if (s == 0 || s == 7) {
            pg8::Gemm g{XB, (const bf16_t*)(wl + (s == 0 ? WL_GU1 : WL_GU2)), M, 2 * FF, D}; pg8::StaticOrder S; S.init(M, 2 * FF, G, (int)blockIdx.x);
            *(LAS f32x4*)(lds + pg8::RINV_LDS_OFF + tid * 48 + 32) = (f32x4){0.f, 0.f, 0.f, 0.f};
            pg8::EpiSwiGLU E{(bf16_t*)R, FF, SSQ, lds};
            pg8::gemm_phase<pg8::EpiSwiGLU, pg8::StaticOrder, true, true>(lds, g, S, E);
        } else if (s == 1 || s == 8 || s == 6) {
            const bf16_t* A = (s == 6) ? OB : (const bf16_t*)R; const int K = (s == 6) ? D : FF;
            const bf16_t* Bt = (const bf16_t*)(wl + (s == 6 ? WL_WOUT : (s == 1 ? WL_DN1 : WL_DN2)));
            const float* base32 = (l == 0 && s == 1) ? kin(0) : nullptr; float* out32 = nullptr;
            pg8::Gemm g{A, Bt, M, D, K}; pg8::StaticOrder S; S.init(M, D, G, (int)blockIdx.x);
            pg8::EpiResid E{base32, out32, XB, SSQ, D, s == 6 ? 1.0f : 0.5f};
            pg8::gemm_phase<pg8::EpiResid, pg8::StaticOrder, true, true>(lds, g, S, E);
        } else if (s == 2) {
            pg8::Gemm g{XB, (const bf16_t*)(wl + WL_WIN), M, DIN, D}; pg8::StaticOrder S; S.init(M, DIN, G, (int)blockIdx.x);
            *(LAS f32x4*)(lds + pg8::RINV_LDS_OFF + tid * 48 + 32) = (f32x4){0.f, 0.f, 0.f, 0.f};
            pg8::EpiMix E{R, LBS + l * AW, SSQ, lds};
            pg8::gemm_phase<pg8::EpiMix, pg8::StaticOrder, true, true>(lds, g, S, E);
        } else if (s == 3) {
            float* DBUF = (float*)(ws + WS_DBUF);
            for (int u = blockIdx.x; u < 2048; u += G) hgrn_pass1(lds, R, (bf16_t*)X, DBUF, LBS + l * AW, u, tid);
            for (int u = blockIdx.x; u < NB * 64; u += G)
                gmlp_mfma(lds, R, OB, kin(9) + l * AW, kin(10) + l * AW, kin(11) + (size_t)l * 4 * 128 * 128, kin(12) + l * 4 * 128, u, tid);
        } else if (s == 4) {
            for (int it = blockIdx.x; it < 256; it += G) hgrn_scan((unsigned*)X, (const float*)(ws + WS_DBUF), it, tid);
        } else if (s == 5) {
            for (int u = blockIdx.x; u < 2048; u += G) hgrn_pass3(lds, R, (const bf16_t*)X, OB, kin(8) + l * AW, LBS + l * AW, u, tid);
        }
    }
}

#ifndef MK_COOP
#define MK_COOP 1
#endif
extern "C" void kernel_launch(void* const* d_in, const int* in_sizes, int n_in, void* d_out, int out_size, void* d_ws, size_t ws_size, hipStream_t stream) {
    static int grid = 0;
    if (grid == 0) {
        if (n_in != 19 || out_size != M * D || ws_size < WS_END) { fprintf(stderr, "kernel_launch: unexpected sizes n_in %d out %d ws %zu\n", n_in, out_size, ws_size); grid = -1; return; }
        int dev = 0, cus = 0, per_cu = 0;
        hipGetDevice(&dev); hipDeviceGetAttribute(&cus, hipDeviceAttributeMultiprocessorCount, dev);
        if (hipFuncSetAttribute((const void*)mega, hipFuncAttributeMaxDynamicSharedMemorySize, LDS_BYTES) != hipSuccess) { fprintf(stderr, "kernel_launch: hipFuncSetAttribute failed\n"); grid = -1; return; }
        if (hipOccupancyMaxActiveBlocksPerMultiprocessor(&per_cu, (const void*)mega, 512, LDS_BYTES) != hipSuccess || per_cu < 1) { fprintf(stderr, "kernel_launch: occupancy query says %d\n", per_cu); per_cu = 1; }
        (void)hipGetLastError();
        grid = cus * per_cu;
    }
    if (grid < 0) return;
    Params a{};
    for (int i = 0; i < 19; ++i) a.in[i] = (const float*)d_in[i];
    a.out = (float*)d_out; a.ws = (unsigned char*)d_ws;
    if (hipMemsetAsync((char*)d_ws + WS_BAR, 0, BAR_BYTES, stream) != hipSuccess) { fprintf(stderr, "kernel_launch: memset of the barrier words failed\n"); return; }
#if MK_COOP
    a.ph_lo = 0; a.ph_hi = NPHASE;
    void* args[] = {&a};
    hipError_t e = hipLaunchCooperativeKernel((const void*)mega, dim3(grid), dim3(512), args, LDS_BYTES, stream);
    if (e != hipSuccess) fprintf(stderr, "cooperative launch failed: %s (grid %d)\n", hipGetErrorString(e), grid);
#else
    for (int ph = 0; ph < NPHASE; ++ph) { a.ph_lo = ph; a.ph_hi = ph + 1; hipLaunchKernelGGL(mega, dim3(grid), dim3(512), LDS_BYTES, stream, a); }
#endif
}
```

```cpp
#include <hip/hip_runtime.h>
#include <hip/hip_cooperative_groups.h>
#include <cstdio>
#include <cstdint>
namespace cg = cooperative_groups;
namespace pg8 {
#define PG8_LAS __attribute__((address_space(3)))
typedef unsigned short bf16_t;
typedef short bf16x8 __attribute__((ext_vector_type(8)));
typedef float f32x4 __attribute__((ext_vector_type(4)));
typedef unsigned u32x4 __attribute__((ext_vector_type(4)));
constexpr int BM = 256, BK = 64, HALF = 128, HTB = HALF * BK * 2  , STAGE_BYTES = 8 * HTB, NXCD = 8, WGM = 8;

__host__ __device__ __forceinline__ int lds_byte(int r, int c) { const int st = (r >> 4) * 2 + (c >> 5), rr = r & 15, cc = c & 31, ob = rr * 64 + cc * 2; return st * 1024 + (ob ^ (((ob >> 9) & 1) << 5)); }
__host__ __device__ __forceinline__ void stage_rc(int b, int& R, int& C) { const int st = b / 1024, sb = b % 1024, swz = sb ^ (((sb >> 9) & 1) << 5); R = (st >> 1) * 16 + swz / 64; C = (st & 1) * 32 + (swz % 64) / 2; }
__host__ __device__ __forceinline__ int perm32(int rho) { const int n = rho >> 4, i = rho & 15; return 8 * (i >> 2) + 4 * n + (i & 3); }

struct Unit { int pm, pn; };
struct Gemm { const bf16_t* A; const bf16_t* Bt; int M, N, K; };

struct StaticOrder {
    int nM, nN, nwg, G, c;
    __host__ __device__ void init(int M, int N, int G_, int c_) { nM = M / BM; nN = N / BM; nwg = nM * nN; G = G_; c = c_; }
    __host__ __device__ bool next(int i, Unit& u) const {
        const long L = (long)i * G + c; if (L >= nwg) return false;
        int wgid = (int)L; { const int q = nwg / NXCD, r = nwg % NXCD, xcd = wgid % NXCD, off = wgid / NXCD; wgid = (xcd < r ? xcd * (q + 1) : r * (q + 1) + (xcd - r) * q) + off; }
        const int nig = WGM * nN, gid = wgid / nig, fm = gid * WGM, gsz = (nM - fm) < WGM ? (nM - fm) : WGM;
        u.pm = fm + ((wgid % nig) % gsz); u.pn = (wgid % nig) / gsz; return true;
    }
    __device__ __forceinline__ void a_ready(const Unit&) const {}
    __device__ __forceinline__ void done(const Unit&) const {}
};

typedef __bf16 bf16v2_t __attribute__((ext_vector_type(2))); typedef float f32x2_t __attribute__((ext_vector_type(2)));
__device__ __forceinline__ unsigned cvt_pk_bf16(float lo, float hi) { bf16v2_t r = __builtin_convertvector((f32x2_t){lo, hi}, bf16v2_t); return __builtin_bit_cast(unsigned, r); }
typedef float f32x2 __attribute__((ext_vector_type(2)));
template <class Epi, class Sched, bool ALIGN_EPI = false, bool SP2 = false>
__device__ __forceinline__ void gemm_phase(PG8_LAS unsigned char* lds, const Gemm g, const Sched& S, const Epi& E) {
    int tid_ = threadIdx.x; asm volatile("" : "+v"(tid_));
    const int tid = tid_, wid = __builtin_amdgcn_readfirstlane(tid >> 6), lane = tid & 63, wr = wid >> 2, wc = wid & 3, fr = lane & 15, fq = lane >> 4;
    const int K = g.K, nt = K / BK;
    unsigned voffA[2], voffB[2];
#pragma unroll
    for (int i = 0; i < 2; ++i) { int R, C; stage_rc(tid * 16 + i * 8192, R, C); const int Rb = Epi::PERM ? ((R & ~31) + perm32(R & 31)) : R;
        voffA[i] = (unsigned)(R * K + C) * 2u; voffB[i] = (unsigned)(Rb * K + C) * 2u; }
    const size_t kstep = (size_t)(BK * 2);
    const size_t hstep = (size_t)HALF * K * 2;
    const size_t tstep = 2 * hstep;
    const unsigned ldsw = (unsigned)wid * 1024u;
    const int aoff = lds_byte(wr * 64 + fr, fq * 8), boff = lds_byte(wc * 32 + fr, fq * 8);
#define PG8_SA(b, h) (((b) * 2 + (h)) * HTB)
#define PG8_SB(b, h) ((4 + (b) * 2 + (h)) * HTB)
#define PG8_STAGE(bufoff, gbase, voff) do { _Pragma("unroll") for (int _i = 0; _i < 2; ++_i) \
        __builtin_amdgcn_global_load_lds((const unsigned*)((const char*)(gbase) + (voff)[_i]), (PG8_LAS unsigned*)(lds + (bufoff) + ldsw + _i * 8192), 16, 0, 0); } while (0)
#define PG8_LDA(dst, b, h) do { _Pragma("unroll") for (int m = 0; m < 4; ++m) _Pragma("unroll") for (int k = 0; k < 2; ++k) dst[m][k] = *(const PG8_LAS bf16x8*)(lds + PG8_SA(b, h) + aoff + m * 2048 + k * 1024); } while (0)
#define PG8_LDB(dst, b, h) do { _Pragma("unroll") for (int n = 0; n < 2; ++n) _Pragma("unroll") for (int k = 0; k < 2; ++k) dst[n][k] = *(const PG8_LAS bf16x8*)(lds + PG8_SB(b, h) + boff + n * 2048 + k * 1024); } while (0)
#define PG8_MMA(ai, bj, At, Bt) do { __builtin_amdgcn_s_setprio(1); _Pragma("unroll") for (int m = 0; m < 4; ++m) _Pragma("unroll") for (int n = 0; n < 2; ++n) _Pragma("unroll") for (int k = 0; k < 2; ++k) \
        acc[ai][bj][m][n] = __builtin_amdgcn_mfma_f32_16x16x32_bf16(Bt[n][k], At[m][k], acc[ai][bj][m][n], 0, 0, 0); __builtin_amdgcn_s_setprio(0); } while (0)
#define PG8_WAIT_V(n) asm volatile("s_waitcnt vmcnt(" #n ")" ::: "memory")
#define PG8_WAIT_L(n) asm volatile("s_waitcnt lgkmcnt(" #n ")" ::: "memory")
#define PG8_BAR __builtin_amdgcn_s_barrier()
#define PG8_SCHED __builtin_amdgcn_sched_barrier(0)
    Unit cur, nxt; int ui = 0;
    if (!S.next(0, cur)) return;
    f32x4 acc[2][2][4][2];
#pragma unroll
    for (int a = 0; a < 2; ++a)
#pragma unroll
        for (int b = 0; b < 2; ++b)
#pragma unroll
            for (int m = 0; m < 4; ++m)
#pragma unroll
                for (int n = 0; n < 2; ++n) acc[a][b][m][n] = (f32x4){0.f, 0.f, 0.f, 0.f};
    bf16x8 At[4][2], B0[2][2], B1[2][2];
    const char* cA = (const char*)g.A + (size_t)cur.pm * tstep; const char* cB = (const char*)g.Bt + (size_t)cur.pn * tstep;
    S.a_ready(cur);
    if constexpr (SP2) {
        PG8_STAGE(PG8_SB(0, 0), cB, voffB); PG8_STAGE(PG8_SB(0, 1), cB + hstep, voffB); PG8_STAGE(PG8_SA(0, 0), cA, voffA); PG8_STAGE(PG8_SA(0, 1), cA + hstep, voffA);
        if (wr == 1) PG8_BAR;
        PG8_WAIT_V(2); PG8_BAR;
        PG8_STAGE(PG8_SB(1, 0), cB + kstep, voffB); PG8_STAGE(PG8_SA(1, 0), cA + kstep, voffA); PG8_STAGE(PG8_SB(1, 1), cB + hstep + kstep, voffB);
        PG8_WAIT_V(6); PG8_BAR;
    } else {
        PG8_STAGE(PG8_SB(0, 0), cB, voffB); PG8_STAGE(PG8_SA(0, 0), cA, voffA); PG8_STAGE(PG8_SB(0, 1), cB + hstep, voffB); PG8_STAGE(PG8_SA(0, 1), cA + hstep, voffA);
        if (wr == 1) PG8_BAR;
        PG8_WAIT_V(4); PG8_BAR;
        PG8_STAGE(PG8_SB(1, 0), cB + kstep, voffB); PG8_STAGE(PG8_SA(1, 0), cA + kstep, voffA); PG8_STAGE(PG8_SB(1, 1), cB + hstep + kstep, voffB);
        PG8_WAIT_V(6); PG8_BAR;
    }
    for (;;) {
        const bool has_next = S.next(ui + 1, nxt);
        const char* nA = has_next ? (const char*)g.A + (size_t)nxt.pm * tstep : cA; const char* nB = has_next ? (const char*)g.Bt + (size_t)nxt.pn * tstep : cB;
        for (int t = 0; t < nt; t += 2) {
            const bool last = (t == nt - 2);
            const char* a1 = cA + (size_t)(t + 1) * kstep;
            const char* a2 = last ? nA : cA + (size_t)(t + 2) * kstep; const char* b2 = last ? nB : cB + (size_t)(t + 2) * kstep;
            const char* a3 = a2 + kstep; const char* b3 = b2 + kstep;
            if (last && has_next) S.a_ready(nxt);
            if constexpr (SP2) {
            PG8_LDB(B0, 0, 0); PG8_LDB(B1, 0, 1); PG8_SCHED; PG8_LDA(At, 0, 0); PG8_STAGE(PG8_SA(1, 1), a1 + hstep, voffA);
            PG8_WAIT_V(8); PG8_WAIT_L(0); PG8_BAR; PG8_MMA(0, 0, At, B0); PG8_MMA(0, 1, At, B1); PG8_BAR; PG8_SCHED;
            PG8_LDA(At, 0, 1); PG8_STAGE(PG8_SB(0, 0), b2, voffB); PG8_STAGE(PG8_SB(0, 1), b2 + hstep, voffB); PG8_STAGE(PG8_SA(0, 0), a2, voffA);
            PG8_WAIT_V(8); PG8_WAIT_L(0); PG8_BAR; PG8_MMA(1, 0, At, B0); PG8_MMA(1, 1, At, B1); PG8_BAR; PG8_SCHED;
            PG8_LDB(B0, 1, 0); PG8_LDB(B1, 1, 1); PG8_SCHED; PG8_LDA(At, 1, 0); PG8_STAGE(PG8_SA(0, 1), a2 + hstep, voffA);
            PG8_WAIT_V(8); PG8_WAIT_L(0); PG8_BAR; PG8_MMA(0, 0, At, B0); PG8_MMA(0, 1, At, B1); PG8_BAR; PG8_SCHED;
            PG8_LDA(At, 1, 1); PG8_STAGE(PG8_SB(1, 0), b3, voffB); PG8_STAGE(PG8_SB(1, 1), b3 + hstep, voffB); PG8_STAGE(PG8_SA(1, 0), a3, voffA);
            PG8_WAIT_V(8); PG8_WAIT_L(0); PG8_BAR; PG8_MMA(1, 0, At, B0); PG8_MMA(1, 1, At, B1); PG8_BAR; PG8_SCHED;
            } else {
            PG8_LDB(B0, 0, 0); PG8_SCHED; PG8_LDA(At, 0, 0); PG8_STAGE(PG8_SA(1, 1), a1 + hstep, voffA);
            PG8_WAIT_L(8); PG8_BAR; PG8_WAIT_L(0); PG8_MMA(0, 0, At, B0); PG8_BAR; PG8_SCHED;
            PG8_LDB(B1, 0, 1); PG8_STAGE(PG8_SB(0, 0), b2, voffB);
            PG8_BAR; PG8_WAIT_L(0); PG8_MMA(0, 1, At, B1); PG8_BAR;
            PG8_LDA(At, 0, 1); PG8_STAGE(PG8_SA(0, 0), a2, voffA);
            PG8_BAR; PG8_WAIT_L(0); PG8_MMA(1, 0, At, B0); PG8_BAR; PG8_SCHED;
            PG8_STAGE(PG8_SB(0, 1), b2 + hstep, voffB);
            PG8_WAIT_V(6); PG8_BAR; PG8_MMA(1, 1, At, B1); PG8_BAR;
            PG8_LDB(B0, 1, 0); PG8_SCHED; PG8_LDA(At, 1, 0); PG8_STAGE(PG8_SA(0, 1), a2 + hstep, voffA);
            PG8_WAIT_L(8); PG8_BAR; PG8_WAIT_L(0); PG8_MMA(0, 0, At, B0); PG8_BAR; PG8_SCHED;
            PG8_LDB(B1, 1, 1); PG8_STAGE(PG8_SB(1, 0), b3, voffB);
            PG8_BAR; PG8_WAIT_L(0); PG8_MMA(0, 1, At, B1); PG8_BAR;
            PG8_LDA(At, 1, 1); PG8_STAGE(PG8_SA(1, 0), a3, voffA);
            PG8_BAR; PG8_WAIT_L(0); PG8_MMA(1, 0, At, B0); PG8_BAR; PG8_SCHED;
            PG8_STAGE(PG8_SB(1, 1), b3 + hstep, voffB);
            PG8_WAIT_V(6); PG8_BAR; PG8_MMA(1, 1, At, B1); PG8_BAR;
            }
        }
        if constexpr (ALIGN_EPI) { if (wr == 0) PG8_BAR; }
        if constexpr (!Epi::AFTER_DRAIN) { E(acc, cur, wr, wc, fr, fq); S.done(cur); }
        if (!has_next) break;
#pragma unroll
        for (int a = 0; a < 2; ++a)
#pragma unroll
            for (int b = 0; b < 2; ++b)
#pragma unroll
                for (int m = 0; m < 4; ++m)
#pragma unroll
                    for (int n = 0; n < 2; ++n) acc[a][b][m][n] = (f32x4){0.f, 0.f, 0.f, 0.f};
        cur = nxt; cA = nA; cB = nB; ++ui;
        if constexpr (ALIGN_EPI) { if (wr == 1) PG8_BAR; }
    }
    PG8_WAIT_V(0);
    if constexpr (!ALIGN_EPI) { if (wr == 0) PG8_BAR; }
    PG8_BAR;
    if constexpr (Epi::AFTER_DRAIN) { E.fused(acc, cur, wr, wc, fr, fq, lds, wid, lane); S.done(cur); }
#undef PG8_SA
#undef PG8_SB
#undef PG8_STAGE
#undef PG8_LDA
#undef PG8_LDB
#undef PG8_MMA
#undef PG8_WAIT_V
#undef PG8_WAIT_L
#undef PG8_BAR
#undef PG8_SCHED
}
}
namespace pg8 {
__device__ __forceinline__ float sigm(float x) { return __builtin_amdgcn_rcpf(1.0f + __expf(-x)); }
__device__ __forceinline__ float gelu_tanh(float x) { return x * sigm(1.5957691216f * (x + 0.044715f * x * x * x)); }

__device__ __forceinline__ float row_rinv(const float* ssq, int row) {
    const f32x4* p = (const f32x4*)(ssq + (size_t)row * 16); const f32x4 a = p[0], b = p[1], c = p[2], d = p[3];
    const float s = (((a[0] + a[1]) + (a[2] + a[3])) + ((b[0] + b[1]) + (b[2] + b[3]))) + (((c[0] + c[1]) + (c[2] + c[3])) + ((d[0] + d[1]) + (d[2] + d[3])));
    return rsqrtf(s * (1.0f / 1024.0f) + 1e-6f);
}
constexpr int RINV_LDS_OFF = 131072 + 2048;
struct RowRinv8 {
    float r[2][4];
    __device__ __forceinline__ void load(const float* ssq, int row0, int fq, int pm, PG8_LAS unsigned char* lds) {
        PG8_LAS f32x4* slot = (PG8_LAS f32x4*)(lds + RINV_LDS_OFF + (int)threadIdx.x * 48);
        const f32x4 t = slot[2];
        if (__float_as_int(t[0]) == pm + 1) { const f32x4 a = slot[0], b = slot[1]; r[0][0] = a[0]; r[0][1] = a[1]; r[0][2] = a[2]; r[0][3] = a[3]; r[1][0] = b[0]; r[1][1] = b[1]; r[1][2] = b[2]; r[1][3] = b[3]; }
        else {
            f32x4 p[2][4];
#pragma unroll
            for (int ai = 0; ai < 2; ++ai)
#pragma unroll
                for (int m = 0; m < 4; ++m) p[ai][m] = *(const f32x4*)(ssq + (size_t)(row0 + ai * HALF + m * 16) * 16 + 4 * fq);
#pragma unroll
            for (int ai = 0; ai < 2; ++ai)
#pragma unroll
                for (int m = 0; m < 4; ++m) { float s = (p[ai][m][0] + p[ai][m][1]) + (p[ai][m][2] + p[ai][m][3]); s += __shfl_xor(s, 16); s += __shfl_xor(s, 32); r[ai][m] = rsqrtf(s * (1.0f / 1024.0f) + 1e-6f); }
            slot[0] = (f32x4){r[0][0], r[0][1], r[0][2], r[0][3]}; slot[1] = (f32x4){r[1][0], r[1][1], r[1][2], r[1][3]}; slot[2] = (f32x4){__int_as_float(pm + 1), 0.f, 0.f, 0.f};
        }
    }
    __device__ __forceinline__ float get(int ai, int m) const { return r[ai][m]; }
};
struct EpiSwiGLU {
    static constexpr bool PERM = true, AFTER_DRAIN = false;
    bf16_t* O; int ldc; const float* ssq; PG8_LAS unsigned char* lds;
    __device__ __forceinline__ void operator()(const f32x4 (&acc)[2][2][4][2], const Unit& u, int wr, int wc, int fr, int fq) const {
        const int row0 = u.pm * BM + wr * 64 + fr, col0 = u.pn * HALF + wc * 32 + 8 * fq;
        RowRinv8 rr; rr.load(ssq, row0, fq, u.pm, lds);
#pragma unroll
        for (int ai = 0; ai < 2; ++ai)
#pragma unroll
            for (int m = 0; m < 4; ++m) {
                bf16_t* rowp = O + (size_t)(row0 + ai * HALF + m * 16) * ldc + col0;
                const float ri = rr.get(ai, m);
                float r[8];
#pragma unroll
                for (int n = 0; n < 2; ++n)
#pragma unroll
                    for (int j = 0; j < 4; ++j) { const float g = acc[ai][0][m][n][j] * ri, up = acc[ai][1][m][n][j] * ri; r[n * 4 + j] = g * sigm(g) * up; }
                u32x4 w; w.x = cvt_pk_bf16(r[0], r[1]); w.y = cvt_pk_bf16(r[2], r[3]); w.z = cvt_pk_bf16(r[4], r[5]); w.w = cvt_pk_bf16(r[6], r[7]);
                *(u32x4*)rowp = w;
            }
    }
};

struct EpiResid {
    static constexpr bool PERM = false, AFTER_DRAIN = false;
    const float* base32; float* out32; bf16_t* xb; float* ssq; int ldc; float scale;
    typedef unsigned u32x2_ __attribute__((ext_vector_type(2)));
    static __device__ __forceinline__ f32x4 unpack4(u32x2_ t) { return (f32x4){__uint_as_float(t.x << 16), __uint_as_float(t.x & 0xffff0000u), __uint_as_float(t.y << 16), __uint_as_float(t.y & 0xffff0000u)}; }
    __device__ __forceinline__ void operator()(const f32x4 (&acc)[2][2][4][2], const Unit& u, int wr, int wc, int fr, int fq) const {
        const int row0 = u.pm * BM + wr * 64 + fr, col0 = u.pn * BM + wc * 32 + 4 * fq;
        if (base32) {
#pragma unroll
            for (int ai = 0; ai < 2; ++ai)
#pragma unroll
                for (int m = 0; m < 4; ++m) {
                    const int row = row0 + ai * HALF + m * 16; const size_t off = (size_t)row * ldc + col0; float ss = 0.f;
#pragma unroll
                    for (int bj = 0; bj < 2; ++bj)
#pragma unroll
                        for (int n = 0; n < 2; ++n) { const size_t o = off + bj * HALF + n * 16; const f32x4 b = *(const f32x4*)(base32 + o);
                            f32x4 v = b + acc[ai][bj][m][n] * scale;
                            u32x2_ w; w.x = cvt_pk_bf16(v[0], v[1]); w.y = cvt_pk_bf16(v[2], v[3]); *(u32x2_*)(xb + o) = w;
                            if (out32) *(f32x4*)(out32 + o) = v; else v = unpack4(w);
                            ss += (v[0] * v[0] + v[1] * v[1]) + (v[2] * v[2] + v[3] * v[3]); }
                    ss += __shfl_xor(ss, 16); ss += __shfl_xor(ss, 32);
                    if (fq == 0) ssq[(size_t)row * 16 + 4 * u.pn + wc] = ss;
                    if (m & 1) asm volatile("" ::: "memory");
                }
        } else {
#pragma unroll
            for (int ai = 0; ai < 2; ++ai) {
                u32x2_ bb[4][2][2];
#pragma unroll
                for (int m = 0; m < 4; ++m)
#pragma unroll
                    for (int bj = 0; bj < 2; ++bj)
#pragma unroll
                        for (int n = 0; n < 2; ++n) bb[m][bj][n] = *(const u32x2_*)(xb + (size_t)(row0 + ai * HALF + m * 16) * ldc + col0 + bj * HALF + n * 16);
#pragma unroll
                for (int m = 0; m < 4; ++m) {
                    const int row = row0 + ai * HALF + m * 16; const size_t off = (size_t)row * ldc + col0; float ss = 0.f;
#pragma unroll
                    for (int bj = 0; bj < 2; ++bj)
#pragma unroll
                        for (int n = 0; n < 2; ++n) { const size_t o = off + bj * HALF + n * 16;
                            f32x4 v = unpack4(bb[m][bj][n]) + acc[ai][bj][m][n] * scale;
                            u32x2_ w; w.x = cvt_pk_bf16(v[0], v[1]); w.y = cvt_pk_bf16(v[2], v[3]); *(u32x2_*)(xb + o) = w;
                            if (out32) *(f32x4*)(out32 + o) = v; else v = unpack4(w);
                            ss += (v[0] * v[0] + v[1] * v[1]) + (v[2] * v[2] + v[3] * v[3]); }
                    ss += __shfl_xor(ss, 16); ss += __shfl_xor(ss, 32);
                    if (fq == 0) ssq[(size_t)row * 16 + 4 * u.pn + wc] = ss;
                }
                asm volatile("" ::: "memory");
            }
        }
    }
};

struct EpiMix {
    static constexpr bool PERM = true, AFTER_DRAIN = false;
    unsigned char* R; const float* lb; const float* ssq; PG8_LAS unsigned char* lds;
    __device__ __forceinline__ void operator()(const f32x4 (&acc)[2][2][4][2], const Unit& u, int wr, int wc, int fr, int fq) const {
        const int seg = u.pn >> 1;
        const int colb = (u.pn & 1) * 256 + wc * 32 + 8 * fq, row0 = u.pm * BM + wr * 64 + fr;
        RowRinv8 rr; rr.load(ssq, row0, fq, u.pm, lds);
        if (seg <= 1) {
            float* LF = (float*)(R + (seg == 0 ? (size_t)0 : ((size_t)64 << 20)));
#pragma unroll
            for (int bj = 0; bj < 2; ++bj) {
#pragma unroll
                for (int ai = 0; ai < 2; ++ai)
#pragma unroll
                    for (int m = 0; m < 4; ++m) {
                        float* rowp = LF + (size_t)(row0 + ai * HALF + m * 16) * 512 + colb + bj * HALF;
                        const float ri = rr.get(ai, m);
                        f32x4 o0, o1;
                        o0 = acc[ai][bj][m][0] * ri; o1 = acc[ai][bj][m][1] * ri;
                        *(f32x4*)rowp = o0; *(f32x4*)(rowp + 4) = o1;
                    }
            }
        } else {
            const size_t boff = (size_t)(64 + 32 * seg) << 20;
            bf16_t* B = (bf16_t*)(R + boff);
#pragma unroll
            for (int ai = 0; ai < 2; ++ai)
#pragma unroll
                for (int m = 0; m < 4; ++m) {
                    const float ri = rr.get(ai, m);
#pragma unroll
                    for (int bj = 0; bj < 2; ++bj) {
                        bf16_t* rowp = B + (size_t)(row0 + ai * HALF + m * 16) * 512 + colb + bj * HALF;
                        float r[8];
#pragma unroll
                        for (int n = 0; n < 2; ++n)
#pragma unroll
                            for (int j = 0; j < 4; ++j) { const float x = acc[ai][bj][m][n][j] * ri; r[n * 4 + j] = x; }
                        u32x4 w; w.x = cvt_pk_bf16(r[0], r[1]); w.y = cvt_pk_bf16(r[2], r[3]); w.z = cvt_pk_bf16(r[4], r[5]); w.w = cvt_pk_bf16(r[6], r[7]);
                        *(u32x4*)rowp = w;
                    } }
        }
    }
};
}
constexpr int NB = 4, SEQ = 8192, D = 1024, FF = 2816, DIN = 3072, AW = 512, NLAYER = 2;
constexpr int M = NB * SEQ;
constexpr float EPS = 1e-6f;
#define LAS __attribute__((address_space(3)))
typedef pg8::bf16_t bf16_t;
typedef float f32x4 __attribute__((ext_vector_type(4)));
typedef float f32x2 __attribute__((ext_vector_type(2)));
typedef unsigned u32x4 __attribute__((ext_vector_type(4)));
typedef unsigned u32x2 __attribute__((ext_vector_type(2)));
constexpr size_t MiB = 1u << 20;
constexpr size_t WL_GU1 = 0, WL_DN1 = 11 * MiB, WL_WIN = WL_DN1 + 11 * MiB / 2, WL_WOUT = WL_WIN + 6 * MiB, WL_GU2 = WL_WOUT + 2 * MiB, WL_DN2 = WL_GU2 + 11 * MiB, WL_STRIDE = 41 * MiB;
static_assert(WL_DN2 + 11 * MiB / 2 == WL_STRIDE, "weights");
constexpr size_t WS_BAR = 82 * MiB + 65536, BAR_BYTES = 16384;
constexpr size_t WS_LBS = 82 * MiB, WS_DBUF = 83 * MiB, WS_SSQ = 84 * MiB;
constexpr size_t WS_XB = 86 * MiB;
constexpr size_t WS_R = 150 * MiB;
constexpr size_t R_Q = 0, R_LF = 64 * MiB, R_V = 128 * MiB, R_G = 160 * MiB, R_U = 192 * MiB, R_VV = 224 * MiB, R_O = 256 * MiB;
constexpr size_t WS_END = WS_R + R_O + 64 * MiB;
constexpr int LDS_BYTES = 131072 + 2048 + 512 * 48;

__device__ __forceinline__ float bf2f(unsigned h) { return __uint_as_float(h << 16); }
__device__ __forceinline__ float wave_sum(float v) {
#pragma unroll
    for (int o = 1; o < 64; o <<= 1) v += __shfl_xor(v, o);
    return v;
}
#define LDS_WAIT() asm volatile("s_waitcnt lgkmcnt(0)" ::: "memory")

__device__ __forceinline__ void transpose_item(const float* W, int K, int N, bf16_t* WT, int k0, int n0, int drow0, const float* gain, LAS float* scr, int lane) {
    f32x4 v[8]; float gk[8];
#pragma unroll
    for (int i = 0; i < 8; ++i) { const int kk = 8 * i + (lane >> 3); v[i] = *(const f32x4*)(W + (size_t)(k0 + kk) * N + n0 + (lane & 7) * 4); gk[i] = gain ? gain[k0 + kk] : 1.0f; }
#pragma unroll
    for (int i = 0; i < 8; ++i) { const int kk = 8 * i + (lane >> 3); LAS float* d = scr + kk * 33 + (lane & 7) * 4; d[0] = v[i][0] * gk[i]; d[1] = v[i][1] * gk[i]; d[2] = v[i][2] * gk[i]; d[3] = v[i][3] * gk[i]; }
    LDS_WAIT(); asm volatile("" ::: "memory");
    const int c = lane & 7;
#pragma unroll
    for (int j = 0; j < 4; ++j) { const int n = (lane >> 3) + 8 * j; const LAS float* s = scr + (8 * c) * 33 + n;
        u32x4 o; o.x = pg8::cvt_pk_bf16(s[0 * 33], s[1 * 33]); o.y = pg8::cvt_pk_bf16(s[2 * 33], s[3 * 33]); o.z = pg8::cvt_pk_bf16(s[4 * 33], s[5 * 33]); o.w = pg8::cvt_pk_bf16(s[6 * 33], s[7 * 33]);
        *(u32x4*)(WT + (size_t)(drow0 + n) * K + k0 + 8 * c) = o; }
    LDS_WAIT(); asm volatile("" ::: "memory");
}

__device__ __forceinline__ void row_to_xb(const float* xrow, bf16_t* orow, float* ssqrow, int lane) {
    const f32x4* xr = (const f32x4*)xrow + lane;
    f32x4 v[4]; float s = 0.f;
#pragma unroll
    for (int j = 0; j < 4; ++j) { v[j] = xr[64 * j]; s += (v[j].x * v[j].x + v[j].y * v[j].y) + (v[j].z * v[j].z + v[j].w * v[j].w); }
    s = wave_sum(s);
    u32x2* o8 = (u32x2*)orow + lane;
#pragma unroll
    for (int j = 0; j < 4; ++j) { u32x2 o; o.x = pg8::cvt_pk_bf16(v[j].x, v[j].y); o.y = pg8::cvt_pk_bf16(v[j].z, v[j].w); o8[64 * j] = o; }
    if (lane < 4) ((f32x4*)ssqrow)[lane] = (f32x4){lane == 0 ? s : 0.f, 0.f, 0.f, 0.f};
}
__device__ __forceinline__ void final_norm_row(const bf16_t* xrow, float* orow, const float* g, const float* ssq, int row, int lane) {
    const float rinv = pg8::row_rinv(ssq, row);
    const u32x2* xr = (const u32x2*)xrow + lane; const f32x4* gr = (const f32x4*)g + lane; f32x4* o = (f32x4*)orow + lane;
    u32x2 v[4];
#pragma unroll
    for (int j = 0; j < 4; ++j) v[j] = xr[64 * j];
#pragma unroll
    for (int j = 0; j < 4; ++j) { const f32x4 x = (f32x4){bf2f(v[j].x & 0xffff), bf2f(v[j].x >> 16), bf2f(v[j].y & 0xffff), bf2f(v[j].y >> 16)}; o[64 * j] = x * rinv * gr[64 * j]; }
}

#define XB_TMO      128
#define XB_XCNT(j)  (256  + 64 * (j))
#define XB_XSUB(j)  (1280 + 64 * (j))
#define XB_XGEN(j)  (2304 + 64 * (j))
#define XB_TOP      3328
#define XB_TOPGEN   3392
#define XCD_BAR_WORDS 3456
#define XB_SPIN_CAP (1u << 18)

__device__ __forceinline__ unsigned xb_ld(unsigned* p)              { return __hip_atomic_load(p, __ATOMIC_RELAXED, __HIP_MEMORY_SCOPE_AGENT); }
__device__ __forceinline__ unsigned xb_add(unsigned* p, unsigned v) { return __hip_atomic_fetch_add(p, v, __ATOMIC_RELAXED, __HIP_MEMORY_SCOPE_AGENT); }
__device__ __forceinline__ unsigned xb_xcc_id() { return (unsigned)__builtin_amdgcn_s_getreg((3 << 11) | 20) & 0xFu; }
#define XB_SPIN(cond, bar) do { unsigned _sp = 0; while (cond) { __builtin_amdgcn_s_sleep(1); \
    if ((++_sp & 255u) == 0u) { if (xb_ld(&(bar)[XB_TMO])) break; if (_sp > XB_SPIN_CAP) { atomicAdd(&(bar)[XB_TMO], 1u); break; } } } } while (0)

struct XcdBarrier {
    unsigned* bar; unsigned x;
    volatile LAS unsigned* st;
};

__device__ __forceinline__ XcdBarrier xcd_barrier_post(unsigned* bar, volatile LAS unsigned* st) {
    XcdBarrier b; b.bar = bar; b.x = xb_xcc_id(); b.st = st;
    if (threadIdx.x == 0) (void)xb_add(&bar[XB_XCNT(b.x)], 1u);
    return b;
}
__device__ __forceinline__ void xcd_barrier_complete(unsigned* bar, unsigned x, unsigned& nloc, unsigned& nx) {
    const unsigned G = gridDim.x * gridDim.y * gridDim.z;
    unsigned sum, cnt, mine, sp = 0u;
    for (;;) {
        sum = 0u; cnt = 0u; mine = 0u;
#pragma unroll
        for (unsigned j = 0; j < 16; ++j) { const unsigned c = xb_ld(&bar[XB_XCNT(j)]); sum += c; cnt += (c > 0u) ? 1u : 0u; mine = (j == x) ? c : mine; }
        if (sum == G) break;
        __builtin_amdgcn_s_sleep(1);
        if ((++sp & 255u) == 0u) { if (xb_ld(&bar[XB_TMO])) break; if (sp > XB_SPIN_CAP) { atomicAdd(&bar[XB_TMO], 1u); break; } }
    }
    nloc = mine > 0u ? mine : 1u; nx = cnt > 0u ? cnt : 1u;
}

__device__ __forceinline__ void xcd_barrier(const XcdBarrier& b) {
    asm volatile("s_waitcnt vmcnt(0)" ::: "memory");
    __syncthreads();
    if (threadIdx.x == 0) {
        unsigned* bar = b.bar;
        __builtin_amdgcn_s_waitcnt(0);
        unsigned nloc = b.st[0], nx = b.st[1];
        if (nloc == 0u) { xcd_barrier_complete(bar, b.x, nloc, nx); b.st[0] = nloc; b.st[1] = nx; }
        const unsigned old = xb_add(&bar[XB_XSUB(b.x)], 1u);
        const unsigned gen = old / nloc;
        if (old + 1u == (gen + 1u) * nloc) {
            __builtin_amdgcn_fence(__ATOMIC_RELEASE, "agent");
            asm volatile("s_waitcnt vmcnt(0)" ::: "memory");
            const unsigned og = xb_add(&bar[XB_TOP], 1u);
            const unsigned tg = og / nx;
            if (og + 1u == (tg + 1u) * nx) xb_add(&bar[XB_TOPGEN], 1u);
            else XB_SPIN(xb_ld(&bar[XB_TOPGEN]) == tg, bar);
            __builtin_amdgcn_fence(__ATOMIC_ACQUIRE, "agent");
            xb_add(&bar[XB_XGEN(b.x)], 1u);
            asm volatile("s_waitcnt vmcnt(0)" ::: "memory");
        } else {
            XB_SPIN(xb_ld(&bar[XB_XGEN(b.x)]) == gen, bar);
            __builtin_amdgcn_fence(__ATOMIC_ACQUIRE, "agent");
            asm volatile("s_waitcnt vmcnt(0)" ::: "memory");
        }
    }
    __syncthreads();
}

#ifndef PROBE_PREP
#define PROBE_PREP 0
#endif
#ifndef PROBE_SYNCS
#define PROBE_SYNCS 0
#endif
#ifdef PROBE_DUP_S
constexpr int NPHASE = 2 + PROBE_PREP + PROBE_SYNCS + 10 * NLAYER;
#else
constexpr int NPHASE = 2 + PROBE_PREP + PROBE_SYNCS + 9 * NLAYER;
#endif
struct Params { const float* in[19]; float* out; unsigned char* ws; int ph_lo, ph_hi; };
typedef const __attribute__((address_space(4))) unsigned long long* kaptr_t;
__device__ __forceinline__ unsigned long long karg(int i) { kaptr_t ka = (kaptr_t)__builtin_amdgcn_kernarg_segment_ptr(); asm volatile("" : "+s"(ka)); return ka[i]; }
__device__ __forceinline__ const float* kin(int i) { return (const float*)karg(i); }
__device__ __forceinline__ float* kout() { return (float*)karg(19); }
__device__ __forceinline__ unsigned char* kws() { return (unsigned char*)karg(20); }


typedef short bf16x8 __attribute__((ext_vector_type(8)));
#define MFMA16(a, b, c) __builtin_amdgcn_mfma_f32_16x16x32_bf16(a, b, c, 0, 0, 0)
typedef __bf16 bf16v2_t __attribute__((ext_vector_type(2)));
__device__ __forceinline__ unsigned cvt2(float lo, float hi) { bf16v2_t r = __builtin_convertvector((f32x2){lo, hi}, bf16v2_t); return __builtin_bit_cast(unsigned, r); }
#define LDFRAG(base, row, stride_b, kofs) (*(const LAS bf16x8*)((base) + (row) * (stride_b) + (kofs) * 2))
constexpr int KT_STRIDE = 144;
constexpr int QK_STRIDE = 272;

__device__ __forceinline__ float sigm_(float x) { return __builtin_amdgcn_rcpf(1.0f + __expf(-x)); }
__device__ __forceinline__ float gelu_(float x) { return x * sigm_(1.5957691216f * (x + 0.044715f * x * x * x)); }
#define HG_CUMSUM(LFp, tot) \
    float lf[16], a[16]; { const float* lfp = (LFp) + (size_t)(r0 + seg * 16) * AW + h * 128 + k; \
    _Pragma("unroll") for (int i = 0; i < 16; ++i) lf[i] = lfp[(size_t)i * AW]; \
    { const float lb_ = lbp[h * 128 + k]; _Pragma("unroll") for (int i = 0; i < 16; ++i) lf[i] = __logf(fmaxf(lb_ + (1.0f - lb_) * sigm_(lf[i]), 1e-20f)); } \
    float c = 0.f; _Pragma("unroll") for (int i = 0; i < 16; ++i) { c += lf[i]; a[i] = c; } \
    (tot)[seg * 128 + k] = c; } \
    __syncthreads(); \
    const float t0_ = (tot)[k], t1_ = (tot)[128 + k], t2_ = (tot)[256 + k], t3_ = (tot)[384 + k]; \
    const float pre_ = seg == 0 ? 0.f : (seg == 1 ? t0_ : (seg == 2 ? t0_ + t1_ : t0_ + t1_ + t2_)); \
    const float a_last = (t0_ + t1_) + (t2_ + t3_), a_ref = t0_ + t1_; \
    _Pragma("unroll") for (int i = 0; i < 16; ++i) a[i] += pre_;

__device__ __forceinline__ void load_v(u32x4 (&w)[2], const bf16_t* Vp, int tid) {
#pragma unroll
    for (int i = 0; i < 2; ++i) { const int idx = tid + 512 * i, s = idx & 63, vc = idx >> 6; w[i] = *(const u32x4*)(Vp + (size_t)s * AW + vc * 8); }
}
__device__ __forceinline__ void store_vt(LAS unsigned char* vt, const u32x4 (&w)[2], int tid) {
#pragma unroll
    for (int i = 0; i < 2; ++i) { const int idx = tid + 512 * i, s = idx & 63, vc = idx >> 6;
        LAS unsigned short* d = (LAS unsigned short*)(vt + (vc * 8) * KT_STRIDE + s * 2);
        d[0 * (KT_STRIDE / 2)] = (unsigned short)(w[i].x & 0xffff); d[1 * (KT_STRIDE / 2)] = (unsigned short)(w[i].x >> 16);
        d[2 * (KT_STRIDE / 2)] = (unsigned short)(w[i].y & 0xffff); d[3 * (KT_STRIDE / 2)] = (unsigned short)(w[i].y >> 16);
        d[4 * (KT_STRIDE / 2)] = (unsigned short)(w[i].z & 0xffff); d[5 * (KT_STRIDE / 2)] = (unsigned short)(w[i].z >> 16);
        d[6 * (KT_STRIDE / 2)] = (unsigned short)(w[i].w & 0xffff); d[7 * (KT_STRIDE / 2)] = (unsigned short)(w[i].w >> 16); }
}

__device__ __forceinline__ void hgrn_pass1(LAS unsigned char* lds, const unsigned char* R, bf16_t* ST, float* DBUF, const float* lbp, int unit, int tid) {
    const int bh = unit >> 7, n = unit & 127, b = bh >> 2, h = bh & 3; const size_t r0 = (size_t)b * SEQ + n * 64;
    const int k = tid & 127, seg = tid >> 7, lane = tid & 63, w = __builtin_amdgcn_readfirstlane(tid >> 6), fr = lane & 15, fq = lane >> 4;
    LAS unsigned char* kdt = lds; LAS unsigned char* vt = lds + 18432; LAS float* tot = (LAS float*)(lds + 36864);
    const float* LF = (const float*)(R + R_LF); const bf16_t* V = (const bf16_t*)(R + R_V);
    u32x4 vw[2]; load_v(vw, V + r0 * AW + h * 128, tid);
    __syncthreads();
    HG_CUMSUM(LF, tot)
    {   unsigned pk[8];
#pragma unroll
        for (int i = 0; i < 8; ++i) { const float k0 = (1.0f - __expf(lf[2 * i])) * __expf(a_last - a[2 * i]), k1 = (1.0f - __expf(lf[2 * i + 1])) * __expf(a_last - a[2 * i + 1]); pk[i] = cvt2(k0, k1); }
        LAS u32x4* d = (LAS u32x4*)(kdt + k * KT_STRIDE + seg * 32);
        d[0] = (u32x4){pk[0], pk[1], pk[2], pk[3]}; d[1] = (u32x4){pk[4], pk[5], pk[6], pk[7]};
        if (seg == 0) DBUF[(size_t)unit * 128 + k] = __expf(a_last); }
    store_vt(vt, vw, tid);
    __syncthreads();
    bf16x8 bV[2];
#pragma unroll
    for (int ks = 0; ks < 2; ++ks) bV[ks] = LDFRAG(vt, 16 * w + fr, KT_STRIDE, 32 * ks + 8 * fq);
    bf16_t* up = ST + (size_t)unit * 16384 + (size_t)(16 * w + fr) * 128 + 4 * fq;
#pragma unroll
    for (int kt = 0; kt < 8; ++kt) { f32x4 acc = (f32x4){0.f, 0.f, 0.f, 0.f};
#pragma unroll
        for (int ks = 0; ks < 2; ++ks) acc = MFMA16(LDFRAG(kdt, 16 * kt + fr, KT_STRIDE, 32 * ks + 8 * fq), bV[ks], acc);
        u32x2 o; o.x = cvt2(acc[0], acc[1]); o.y = cvt2(acc[2], acc[3]);
        *(u32x2*)(up + 16 * kt) = o; }
}

__device__ __forceinline__ void hgrn_scan(unsigned* STw, const float* DBUF, int item, int tid) {
    const int bh = item >> 4, e2 = (item & 15) * 512 + tid;
    unsigned* Up = STw + (size_t)bh * 128 * 8192 + e2;
    const float* dp = DBUF + (size_t)bh * 128 * 128 + ((2 * e2) & 127);
    float S0 = 0.f, S1 = 0.f;
    for (int n0 = 0; n0 < 128; n0 += 16) {
        unsigned u[16]; f32x2 d[16];
#pragma unroll
        for (int i = 0; i < 16; ++i) { u[i] = Up[(size_t)(n0 + i) * 8192]; d[i] = *(const f32x2*)(dp + (n0 + i) * 128); }
#pragma unroll
        for (int i = 0; i < 16; ++i) { Up[(size_t)(n0 + i) * 8192] = cvt2(S0, S1); S0 = d[i].x * S0 + bf2f(u[i] & 0xffff); S1 = d[i].y * S1 + bf2f(u[i] >> 16); }
    }
}

__device__ __forceinline__ unsigned bf_hi(float x) { return cvt2(x, 0.f) & 0xffffu; }
__device__ __forceinline__ void hgrn_pass3(LAS unsigned char* lds, const unsigned char* R, const bf16_t* ST, bf16_t* O, const float* ng, const float* lbp, int unit, int tid) {
    const int bh = unit >> 7, n = unit & 127, b = bh >> 2, h = bh & 3; const size_t r0 = (size_t)b * SEQ + n * 64;
    const int k = tid & 127, seg = tid >> 7, lane = tid & 63, w = __builtin_amdgcn_readfirstlane(tid >> 6), fr = lane & 15, fq = lane >> 4;
    LAS unsigned char* qmh = lds; LAS unsigned char* qml = lds + 17408; LAS unsigned char* kmh = lds + 34816; LAS unsigned char* kml = lds + 52224; LAS unsigned char* qs = lds + 69632;
    LAS unsigned char* vt = lds + 87040; LAS unsigned char* pp = lds + 105472; LAS float* tot = (LAS float*)(lds + 114688); LAS float* red = (LAS float*)(lds + 116736);
    const float* Q = (const float*)(R + R_Q); const float* LF = (const float*)(R + R_LF); const bf16_t* V = (const bf16_t*)(R + R_V); const bf16_t* GB = (const bf16_t*)(R + R_G);
    const int tt = w & 3, vh = w >> 2;
    bf16x8 aS[4][4];
    { const bf16_t* sp = ST + (size_t)unit * 16384 + (size_t)(64 * vh + fr) * 128 + 8 * fq;
#pragma unroll
      for (int j = 0; j < 4; ++j)
#pragma unroll
        for (int ks = 0; ks < 4; ++ks) aS[j][ks] = *(const bf16x8*)(sp + (size_t)(16 * j) * 128 + 32 * ks); }
    u32x4 vw[2]; load_v(vw, V + r0 * AW + h * 128, tid);
    u32x2 ggv[4]; f32x4 g4v[4];
#pragma unroll
    for (int j = 0; j < 4; ++j) { const int v0 = 16 * (4 * vh + j) + 4 * fq; ggv[j] = *(const u32x2*)(GB + (r0 + 16 * tt + fr) * AW + h * 128 + v0); g4v[j] = *(const f32x4*)(ng + h * 128 + v0); }
    __syncthreads();
    float qv[16];
    { const float* qp = Q + (size_t)(r0 + seg * 16) * AW + h * 128 + k;
#pragma unroll
      for (int i = 0; i < 16; ++i) qv[i] = qp[(size_t)i * AW]; }
    HG_CUMSUM(LF, tot)
#pragma unroll
    for (int i = 0; i < 16; ++i) { const int t = seg * 16 + i; const float kk = 1.0f - __expf(lf[i]);
        const float qmv = qv[i] * __expf(a[i] - a_ref), kmv = kk * __expf(a_ref - a[i]);
        const unsigned qh = bf_hi(qmv), kh = bf_hi(kmv);
        *(LAS unsigned short*)(qmh + t * QK_STRIDE + k * 2) = (unsigned short)qh;
        *(LAS unsigned short*)(qml + t * QK_STRIDE + k * 2) = (unsigned short)bf_hi(qmv - bf2f(qh));
        *(LAS unsigned short*)(kmh + t * QK_STRIDE + k * 2) = (unsigned short)kh;
        *(LAS unsigned short*)(kml + t * QK_STRIDE + k * 2) = (unsigned short)bf_hi(kmv - bf2f(kh));
        *(LAS unsigned short*)(qs + t * QK_STRIDE + k * 2) = (unsigned short)bf_hi(qv[i] * __expf(a[i])); }
    store_vt(vt, vw, tid);
    __syncthreads();
#pragma unroll
    for (int i2 = 0; i2 < 2; ++i2) { const int st = 2 * vh + i2; f32x4 acc = (f32x4){0.f, 0.f, 0.f, 0.f};
        if (st <= tt) {
#pragma unroll
            for (int ks = 0; ks < 4; ++ks) { const bf16x8 kH = LDFRAG(kmh, 16 * st + fr, QK_STRIDE, 32 * ks + 8 * fq), kL = LDFRAG(kml, 16 * st + fr, QK_STRIDE, 32 * ks + 8 * fq);
                const bf16x8 qH = LDFRAG(qmh, 16 * tt + fr, QK_STRIDE, 32 * ks + 8 * fq), qL = LDFRAG(qml, 16 * tt + fr, QK_STRIDE, 32 * ks + 8 * fq);
                acc = MFMA16(kL, qH, acc); acc = MFMA16(kH, qL, acc); acc = MFMA16(kH, qH, acc); }
            const int t = 16 * tt + fr, s0 = 16 * st + 4 * fq;
#pragma unroll
            for (int e = 0; e < 4; ++e) acc[e] = (s0 + e <= t) ? acc[e] : 0.f; }
        u32x2 o; o.x = cvt2(acc[0], acc[1]); o.y = cvt2(acc[2], acc[3]);
        *(LAS u32x2*)(pp + (16 * tt + fr) * KT_STRIDE + (16 * st + 4 * fq) * 2) = o; }
    __syncthreads();
    f32x4 o4[4];
    { bf16x8 bP[2], bQ[4];
#pragma unroll
      for (int ks = 0; ks < 2; ++ks) bP[ks] = LDFRAG(pp, 16 * tt + fr, KT_STRIDE, 32 * ks + 8 * fq);
#pragma unroll
      for (int ks = 0; ks < 4; ++ks) bQ[ks] = LDFRAG(qs, 16 * tt + fr, QK_STRIDE, 32 * ks + 8 * fq);
#pragma unroll
      for (int j = 0; j < 4; ++j) { f32x4 acc = (f32x4){0.f, 0.f, 0.f, 0.f};
#pragma unroll
        for (int ks = 0; ks < 2; ++ks) acc = MFMA16(LDFRAG(vt, 16 * (4 * vh + j) + fr, KT_STRIDE, 32 * ks + 8 * fq), bP[ks], acc);
#pragma unroll
        for (int ks = 0; ks < 4; ++ks) acc = MFMA16(aS[j][ks], bQ[ks], acc);
        o4[j] = acc; } }
    float ss = 0.f;
#pragma unroll
    for (int j = 0; j < 4; ++j) ss += (o4[j][0] * o4[j][0] + o4[j][1] * o4[j][1]) + (o4[j][2] * o4[j][2] + o4[j][3] * o4[j][3]);
    ss += __shfl_xor(ss, 16); ss += __shfl_xor(ss, 32);
    if (fq == 0) red[vh * 64 + 16 * tt + fr] = ss;
    __syncthreads();
    const float rinv = rsqrtf((red[16 * tt + fr] + red[64 + 16 * tt + fr]) * (1.f / 128.f) + EPS);
    const size_t row = r0 + 16 * tt + fr;
#pragma unroll
    for (int j = 0; j < 4; ++j) { const int v0 = 16 * (4 * vh + j) + 4 * fq;
        const f32x4 g4 = g4v[j]; const u32x2 gg = ggv[j];
        const float s0 = bf2f(gg.x & 0xffff), s1 = bf2f(gg.x >> 16), s2 = bf2f(gg.y & 0xffff), s3 = bf2f(gg.y >> 16);
        u32x2 o; o.x = cvt2(o4[j][0] * rinv * g4[0] * (s0 * sigm_(s0)), o4[j][1] * rinv * g4[1] * (s1 * sigm_(s1)));
        o.y = cvt2(o4[j][2] * rinv * g4[2] * (s2 * sigm_(s2)), o4[j][3] * rinv * g4[3] * (s3 * sigm_(s3)));
        *(u32x2*)(O + row * D + h * 128 + v0) = o; }
}

__device__ __forceinline__ void gmlp_mfma(LAS unsigned char* lds, const unsigned char* R, bf16_t* O, const float* lng, const float* lnb, const float* wsp, const float* bsp, int unit, int tid) {
    const int lane = tid & 63, w = __builtin_amdgcn_readfirstlane(tid >> 6), fr = lane & 15, fq = lane >> 4;
    const size_t r0 = (size_t)unit * 128;
    const bf16_t* U = (const bf16_t*)(R + R_U); const bf16_t* VV = (const bf16_t*)(R + R_VV);
    LAS unsigned char* vnt = lds; LAS unsigned char* wt = lds + 34816; LAS float* mu = (LAS float*)(lds + 69632); LAS float* rs = mu + 128;
    __syncthreads();
    for (int i = 0; i < 16; ++i) { const int t = w * 16 + i; const u32x4 x4 = *(const u32x4*)(VV + (r0 + t) * AW + lane * 8);
        float x[8]; x[0] = gelu_(bf2f(x4.x & 0xffff)); x[1] = gelu_(bf2f(x4.x >> 16)); x[2] = gelu_(bf2f(x4.y & 0xffff)); x[3] = gelu_(bf2f(x4.y >> 16)); x[4] = gelu_(bf2f(x4.z & 0xffff)); x[5] = gelu_(bf2f(x4.z >> 16)); x[6] = gelu_(bf2f(x4.w & 0xffff)); x[7] = gelu_(bf2f(x4.w >> 16));
        float s = 0.f;
#pragma unroll
        for (int j = 0; j < 8; ++j) s += x[j];
        const float mean = wave_sum(s) * (1.f / 512.f); float q = 0.f;
#pragma unroll
        for (int j = 0; j < 8; ++j) q += (x[j] - mean) * (x[j] - mean);
        const float rstd = rsqrtf(wave_sum(q) * (1.f / 512.f) + EPS);
        if (lane == 0) { mu[t] = mean; rs[t] = rstd; } }
    __syncthreads();
    for (int g = 0; g < 4; ++g) {
#pragma unroll
        for (int i = 0; i < 4; ++i) { const int idx = tid + 512 * i, s = idx & 127, ch = idx >> 7;
            const u32x4 x4 = *(const u32x4*)(VV + (r0 + s) * AW + g * 128 + ch * 8);
            const f32x4 ga = *(const f32x4*)(lng + g * 128 + ch * 8), gb = *(const f32x4*)(lng + g * 128 + ch * 8 + 4), ba = *(const f32x4*)(lnb + g * 128 + ch * 8), bb = *(const f32x4*)(lnb + g * 128 + ch * 8 + 4);
            const float m_ = mu[s], r_ = rs[s];
            LAS unsigned short* d = (LAS unsigned short*)(vnt + (ch * 8) * QK_STRIDE + s * 2);
            d[0 * (QK_STRIDE / 2)] = (unsigned short)(cvt2((gelu_(bf2f(x4.x & 0xffff)) - m_) * r_ * ga[0] + ba[0], 0.f) & 0xffff);
            d[1 * (QK_STRIDE / 2)] = (unsigned short)(cvt2((gelu_(bf2f(x4.x >> 16)) - m_) * r_ * ga[1] + ba[1], 0.f) & 0xffff);
            d[2 * (QK_STRIDE / 2)] = (unsigned short)(cvt2((gelu_(bf2f(x4.y & 0xffff)) - m_) * r_ * ga[2] + ba[2], 0.f) & 0xffff);
            d[3 * (QK_STRIDE / 2)] = (unsigned short)(cvt2((gelu_(bf2f(x4.y >> 16)) - m_) * r_ * ga[3] + ba[3], 0.f) & 0xffff);
            d[4 * (QK_STRIDE / 2)] = (unsigned short)(cvt2((gelu_(bf2f(x4.z & 0xffff)) - m_) * r_ * gb[0] + bb[0], 0.f) & 0xffff);
            d[5 * (QK_STRIDE / 2)] = (unsigned short)(cvt2((gelu_(bf2f(x4.z >> 16)) - m_) * r_ * gb[1] + bb[1], 0.f) & 0xffff);
            d[6 * (QK_STRIDE / 2)] = (unsigned short)(cvt2((gelu_(bf2f(x4.w & 0xffff)) - m_) * r_ * gb[2] + bb[2], 0.f) & 0xffff);
            d[7 * (QK_STRIDE / 2)] = (unsigned short)(cvt2((gelu_(bf2f(x4.w >> 16)) - m_) * r_ * gb[3] + bb[3], 0.f) & 0xffff); }
#pragma unroll
        for (int i = 0; i < 8; ++i) { const int idx = tid + 512 * i, t = idx >> 5, s0 = (idx & 31) * 4;
            const f32x4 x = *(const f32x4*)(wsp + (size_t)(g * 128 + t) * 128 + s0);
            u32x2 o; o.x = cvt2(s0 <= t ? x[0] : 0.f, s0 + 1 <= t ? x[1] : 0.f); o.y = cvt2(s0 + 2 <= t ? x[2] : 0.f, s0 + 3 <= t ? x[3] : 0.f);
            *(LAS u32x2*)(wt + t * QK_STRIDE + s0 * 2) = o; }
        __syncthreads();
        f32x4 acc[8];
#pragma unroll
        for (int ct = 0; ct < 8; ++ct) acc[ct] = (f32x4){0.f, 0.f, 0.f, 0.f};
        for (int ks = 0; ks <= (w >> 1); ++ks) { const bf16x8 bW = LDFRAG(wt, 16 * w + fr, QK_STRIDE, 32 * ks + 8 * fq);
#pragma unroll
            for (int ct = 0; ct < 8; ++ct) acc[ct] = MFMA16(LDFRAG(vnt, 16 * ct + fr, QK_STRIDE, 32 * ks + 8 * fq), bW, acc[ct]); }
        const int t = 16 * w + fr; const float bt = bsp[g * 128 + t];
#pragma unroll
        for (int ct = 0; ct < 8; ++ct) { const int c0 = g * 128 + 16 * ct + 4 * fq; const u32x2 uu = *(const u32x2*)(U + (r0 + t) * AW + c0);
            u32x2 o; o.x = cvt2(gelu_(bf2f(uu.x & 0xffff)) * (acc[ct][0] + bt), gelu_(bf2f(uu.x >> 16)) * (acc[ct][1] + bt));
            o.y = cvt2(gelu_(bf2f(uu.y & 0xffff)) * (acc[ct][2] + bt), gelu_(bf2f(uu.y >> 16)) * (acc[ct][3] + bt));
            *(u32x2*)(O + (r0 + t) * D + 512 + c0) = o; }
        __syncthreads();
    }
}
__global__ void __launch_bounds__(512, 2) mega(Params p) {
    extern __shared__ __attribute__((aligned(16))) unsigned char lds_raw[];
    LAS unsigned char* lds = (LAS unsigned char*)lds_raw;
    cg::grid_group grid = cg::this_grid();
    const int ph_lo = p.ph_lo, ph_hi = p.ph_hi;
    volatile LAS unsigned* bst = (volatile LAS unsigned*)(lds + 131072 + 1024);
    if (threadIdx.x == 0) { bst[0] = 0u; bst[1] = 0u; }
    __syncthreads();
    const XcdBarrier bar = xcd_barrier_post((unsigned*)(kws() + WS_BAR), bst);
    for (int ph = ph_lo; ph < ph_hi; ++ph) {
        if (ph > ph_lo) {
            if (ph_hi < 0) grid.sync();
            xcd_barrier(bar);
        }
        int tid_ = threadIdx.x; asm volatile("" : "+v"(tid_));
        const int tid = tid_, lane = tid & 63, wave = __builtin_amdgcn_readfirstlane(tid >> 6);
        const int G = gridDim.x, gw = blockIdx.x * 8 + wave, NGW = G * 8;
        unsigned char* ws = kws();
        float* X = kout();
        bf16_t* XB = (bf16_t*)(ws + WS_XB);
        float* SSQ = (float*)(ws + WS_SSQ);
        unsigned char* R = ws + WS_R;
        bf16_t* OB = (bf16_t*)(R + R_O);
        float* LBS = (float*)(ws + WS_LBS);
        if (ph <= PROBE_PREP) {
            LAS float* scr = (LAS float*)(lds + wave * 16384);
            constexpr int IG = 16 * 88, IDN = 44 * 32, IIN = 16 * 96, IOUT = 16 * 32, IL = 6 * IG + IIN + IOUT;
            static_assert(IG == IDN, "items");
            for (int it = gw; it < NLAYER * IL; it += NGW) {
                const int l = it / IL; int r = it % IL;
                unsigned char* wl = ws + (size_t)l * WL_STRIDE;
                const float* W; int K, N, mode = 0; bf16_t* WT; const float* gain = nullptr;
                if (r < IG) { W = kin(2) + (size_t)l * D * FF; K = D; N = FF; WT = (bf16_t*)(wl + WL_GU1); mode = 1; gain = kin(1) + l * D; }
                else if ((r -= IG) < IG) { W = kin(3) + (size_t)l * D * FF; K = D; N = FF; WT = (bf16_t*)(wl + WL_GU1); mode = 2; gain = kin(1) + l * D; }
                else if ((r -= IG) < IDN) { W = kin(4) + (size_t)l * D * FF; K = FF; N = D; WT = (bf16_t*)(wl + WL_DN1); }
                else if ((r -= IDN) < IIN) { W = kin(6) + (size_t)l * D * DIN; K = D; N = DIN; WT = (bf16_t*)(wl + WL_WIN); gain = kin(5) + l * D; }
                else if ((r -= IIN) < IOUT) { W = kin(13) + (size_t)l * D * D; K = D; N = D; WT = (bf16_t*)(wl + WL_WOUT); }
                else if ((r -= IOUT) < IG) { W = kin(15) + (size_t)l * D * FF; K = D; N = FF; WT = (bf16_t*)(wl + WL_GU2); mode = 1; gain = kin(14) + l * D; }
                else if ((r -= IG) < IG) { W = kin(16) + (size_t)l * D * FF; K = D; N = FF; WT = (bf16_t*)(wl + WL_GU2); mode = 2; gain = kin(14) + l * D; }
                else { r -= IG; W = kin(17) + (size_t)l * D * FF; K = FF; N = D; WT = (bf16_t*)(wl + WL_DN2); }
                const int nblk = N / 32, kb = r / nblk, nb = r % nblk, k0 = 64 * kb, n0 = 32 * nb;
                const int drow0 = mode == 0 ? n0 : ((n0 >> 7) * 256 + (n0 & 127) + (mode == 2 ? 128 : 0));
                transpose_item(W, K, N, WT, k0, n0, drow0, gain, scr, lane);
            }
            if (blockIdx.x == 0) { const float a0 = kin(7)[tid], a1 = kin(7)[AW + tid]; LBS[tid] = 0.f; LBS[AW + tid] = 1.0f / (1.0f + __expf(a0 - a1)); }
            for (int m = gw; m < M; m += NGW) row_to_xb(kin(0) + (size_t)m * D, XB + (size_t)m * D, SSQ + (size_t)m * 16, lane);
            continue;
        }
        if (ph >= NPHASE - 1 - PROBE_SYNCS && ph < NPHASE - 1) continue;
        if (ph == NPHASE - 1) {
            for (int m = gw; m < M; m += NGW) final_norm_row(XB + (size_t)m * D, X + (size_t)m * D, kin(18), SSQ, m, lane);
            continue;
        }
#ifdef PROBE_DUP_S
        const int q = ph - 1 - PROBE_PREP, l = q / 10, s0 = q % 10, s = s0 <= PROBE_DUP_S ? s0 : s0 - 1;
        if ((PROBE_DUP_S == 1 || PROBE_DUP_S == 6 || PROBE_DUP_S == 8) && s0 == PROBE_DUP_S + 1 && !(l == 0 && PROBE_DUP_S == 1)) continue;
#else
        const int q = ph - 1 - PROBE_PREP, l = q / 9, s = q % 9;
#endif
        unsigned char* wl = ws + (size_t)l * WL_STRIDE;
        if (s == 0 || s == 7) {
            pg8::Gemm g{XB, (const bf16_t*)(wl + (s == 0 ? WL_GU1 : WL_GU2)), M, 2 * FF, D}; pg8::StaticOrder S; S.init(M, 2 * FF, G, (int)blockIdx.x);
            *(LAS f32x4*)(lds + pg8::RINV_LDS_OFF + tid * 48 + 32) = (f32x4){0.f, 0.f, 0.f, 0.f};
            pg8::EpiSwiGLU E{(bf16_t*)R, FF, SSQ, lds};
            pg8::gemm_phase<pg8::EpiSwiGLU, pg8::StaticOrder, true, true>(lds, g, S, E);
        } else if (s == 1 || s == 8 || s == 6) {
            const bf16_t* A = (s == 6) ? OB : (const bf16_t*)R; const int K = (s == 6) ? D : FF;
            const bf16_t* Bt = (const bf16_t*)(wl + (s == 6 ? WL_WOUT : (s == 1 ? WL_DN1 : WL_DN2)));
            const float* base32 = (l == 0 && s == 1) ? kin(0) : nullptr; float* out32 = nullptr;
            pg8::Gemm g{A, Bt, M, D, K}; pg8::StaticOrder S; S.init(M, D, G, (int)blockIdx.x);
            pg8::EpiResid E{base32, out32, XB, SSQ, D, s == 6 ? 1.0f : 0.5f};
            pg8::gemm_phase<pg8::EpiResid, pg8::StaticOrder, true, true>(lds, g, S, E);
        } else if (s == 2) {
            pg8::Gemm g{XB, (const bf16_t*)(wl + WL_WIN), M, DIN, D}; pg8::StaticOrder S; S.init(M, DIN, G, (int)blockIdx.x);
            *(LAS f32x4*)(lds + pg8::RINV_LDS_OFF + tid * 48 + 32) = (f32x4){0.f, 0.f, 0.f, 0.f};
            pg8::EpiMix E{R, LBS + l * AW, SSQ, lds};
            pg8::gemm_phase<pg8::EpiMix, pg8::StaticOrder, true, true>(lds, g, S, E);
        } else if (s == 3) {
            float* DBUF = (float*)(ws + WS_DBUF);
            for (int u = blockIdx.x; u < 2048; u += G) hgrn_pass1(lds, R, (bf16_t*)X, DBUF, LBS + l * AW, u, tid);
            for (int u = blockIdx.x; u < NB * 64; u += G)
                gmlp_mfma(lds, R, OB, kin(9) + l * AW, kin(10) + l * AW, kin(11) + (size_t)l * 4 * 128 * 128, kin(12) + l * 4 * 128, u, tid);
        } else if (s == 4) {
            for (int it = blockIdx.x; it < 256; it += G) hgrn_scan((unsigned*)X, (const float*)(ws + WS_DBUF), it, tid);
        } else if (s == 5) {
            for (int u = blockIdx.x; u < 2048; u += G) hgrn_pass3(lds, R, (const bf16_t*)X, OB, kin(8) + l * AW, LBS + l * AW, u, tid);
        }
    }
}

#ifndef MK_COOP
#define MK_COOP 1
#endif
extern "C" void kernel_launch(void* const* d_in, const int* in_sizes, int n_in, void* d_out, int out_size, void* d_ws, size_t ws_size, hipStream_t stream) {
    static int grid = 0;
    if (grid == 0) {
        if (n_in != 19 || out_size != M * D || ws_size < WS_END) { fprintf(stderr, "kernel_launch: unexpected sizes n_in %d out %d ws %zu\n", n_in, out_size, ws_size); grid = -1; return; }
        int dev = 0, cus = 0, per_cu = 0;
        hipGetDevice(&dev); hipDeviceGetAttribute(&cus, hipDeviceAttributeMultiprocessorCount, dev);
        if (hipFuncSetAttribute((const void*)mega, hipFuncAttributeMaxDynamicSharedMemorySize, LDS_BYTES) != hipSuccess) { fprintf(stderr, "kernel_launch: hipFuncSetAttribute failed\n"); grid = -1; return; }
        if (hipOccupancyMaxActiveBlocksPerMultiprocessor(&per_cu, (const void*)mega, 512, LDS_BYTES) != hipSuccess || per_cu < 1) { fprintf(stderr, "kernel_launch: occupancy query says %d\n", per_cu); per_cu = 1; }
        (void)hipGetLastError();
        grid = cus * per_cu;
    }
    if (grid < 0) return;
    Params a{};
    for (int i = 0; i < 19; ++i) a.in[i] = (const float*)d_in[i];
    a.out = (float*)d_out; a.ws = (unsigned char*)d_ws;
    if (hipMemsetAsync((char*)d_ws + WS_BAR, 0, BAR_BYTES, stream) != hipSuccess) { fprintf(stderr, "kernel_launch: memset of the barrier words failed\n"); return; }
#if MK_COOP
    a.ph_lo = 0; a.ph_hi = NPHASE;
    void* args[] = {&a};
    hipError_t e = hipLaunchCooperativeKernel((const void*)mega, dim3(grid), dim3(512), args, LDS_BYTES, stream);
    if (e != hipSuccess) fprintf(stderr, "cooperative launch failed: %s (grid %d)\n", hipGetErrorString(e), grid);
#else
    for (int ph = 0; ph < NPHASE; ++ph) { a.ph_lo = ph; a.ph_hi = ph + 1; hipLaunchKernelGGL(mega, dim3(grid), dim3(512), LDS_BYTES, stream, a); }
#endif
}
```

```cpp
#include <hip/hip_runtime.h>
#include <hip/hip_cooperative_groups.h>
#include <cstdio>
#include <cstdint>
namespace cg = cooperative_groups;
namespace pg8 {
#define PG8_LAS __attribute__((address_space(3)))
typedef unsigned short bf16_t;
typedef short bf16x8 __attribute__((ext_vector_type(8)));
typedef float f32x4 __attribute__((ext_vector_type(4)));
typedef unsigned u32x4 __attribute__((ext_vector_type(4)));
constexpr int BM = 256, BK = 64, HALF = 128, HTB = HALF * BK * 2  , STAGE_BYTES = 8 * HTB, NXCD = 8, WGM = 8;

__host__ __device__ __forceinline__ int lds_byte(int r, int c) { const int st = (r >> 4) * 2 + (c >> 5), rr = r & 15, cc = c & 31, ob = rr * 64 + cc * 2; return st * 1024 + (ob ^ (((ob >> 9) & 1) << 5)); }
__host__ __device__ __forceinline__ void stage_rc(int b, int& R, int& C) { const int st = b / 1024, sb = b % 1024, swz = sb ^ (((sb >> 9) & 1) << 5); R = (st >> 1) * 16 + swz / 64; C = (st & 1) * 32 + (swz % 64) / 2; }
__host__ __device__ __forceinline__ int perm32(int rho) { const int n = rho >> 4, i = rho & 15; return 8 * (i >> 2) + 4 * n + (i & 3); }

struct Unit { int pm, pn; };
struct Gemm { const bf16_t* A; const bf16_t* Bt; int M, N, K; };

struct StaticOrder {
    int nM, nN, nwg, G, c;
    __host__ __device__ void init(int M, int N, int G_, int c_) { nM = M / BM; nN = N / BM; nwg = nM * nN; G = G_; c = c_; }
    __host__ __device__ bool next(int i, Unit& u) const {
        const long L = (long)i * G + c; if (L >= nwg) return false;
        int wgid = (int)L; { const int q = nwg / NXCD, r = nwg % NXCD, xcd = wgid % NXCD, off = wgid / NXCD; wgid = (xcd < r ? xcd * (q + 1) : r * (q + 1) + (xcd - r) * q) + off; }
        const int nig = WGM * nN, gid = wgid / nig, fm = gid * WGM, gsz = (nM - fm) < WGM ? (nM - fm) : WGM;
        u.pm = fm + ((wgid % nig) % gsz); u.pn = (wgid % nig) / gsz; return true;
    }
    __device__ __forceinline__ void a_ready(const Unit&) const {}
    __device__ __forceinline__ void done(const Unit&) const {}
};

typedef __bf16 bf16v2_t __attribute__((ext_vector_type(2))); typedef float f32x2_t __attribute__((ext_vector_type(2)));
__device__ __forceinline__ unsigned cvt_pk_bf16(float lo, float hi) { bf16v2_t r = __builtin_convertvector((f32x2_t){lo, hi}, bf16v2_t); return __builtin_bit_cast(unsigned, r); }
typedef float f32x2 __attribute__((ext_vector_type(2)));
template <class Epi, class Sched, bool ALIGN_EPI = false, bool SP2 = false>
__device__ __forceinline__ void gemm_phase(PG8_LAS unsigned char* lds, const Gemm g, const Sched& S, const Epi& E) {
    int tid_ = threadIdx.x; asm volatile("" : "+v"(tid_));
    const int tid = tid_, wid = __builtin_amdgcn_readfirstlane(tid >> 6), lane = tid & 63, wr = wid >> 2, wc = wid & 3, fr = lane & 15, fq = lane >> 4;
    const int K = g.K, nt = K / BK;
    unsigned voffA[2], voffB[2];
#pragma unroll
    for (int i = 0; i < 2; ++i) { int R, C; stage_rc(tid * 16 + i * 8192, R, C); const int Rb = Epi::PERM ? ((R & ~31) + perm32(R & 31)) : R;
        voffA[i] = (unsigned)(R * K + C) * 2u; voffB[i] = (unsigned)(Rb * K + C) * 2u; }
    const size_t kstep = (size_t)(BK * 2);
    const size_t hstep = (size_t)HALF * K * 2;
    const size_t tstep = 2 * hstep;
    const unsigned ldsw = (unsigned)wid * 1024u;
    const int aoff = lds_byte(wr * 64 + fr, fq * 8), boff = lds_byte(wc * 32 + fr, fq * 8);
#define PG8_SA(b, h) (((b) * 2 + (h)) * HTB)
#define PG8_SB(b, h) ((4 + (b) * 2 + (h)) * HTB)
#define PG8_STAGE(bufoff, gbase, voff) do { _Pragma("unroll") for (int _i = 0; _i < 2; ++_i) \
        __builtin_amdgcn_global_load_lds((const unsigned*)((const char*)(gbase) + (voff)[_i]), (PG8_LAS unsigned*)(lds + (bufoff) + ldsw + _i * 8192), 16, 0, 0); } while (0)
#define PG8_LDA(dst, b, h) do { _Pragma("unroll") for (int m = 0; m < 4; ++m) _Pragma("unroll") for (int k = 0; k < 2; ++k) dst[m][k] = *(const PG8_LAS bf16x8*)(lds + PG8_SA(b, h) + aoff + m * 2048 + k * 1024); } while (0)
#define PG8_LDB(dst, b, h) do { _Pragma("unroll") for (int n = 0; n < 2; ++n) _Pragma("unroll") for (int k = 0; k < 2; ++k) dst[n][k] = *(const PG8_LAS bf16x8*)(lds + PG8_SB(b, h) + boff + n * 2048 + k * 1024); } while (0)
#define PG8_MMA(ai, bj, At, Bt) do { __builtin_amdgcn_s_setprio(1); _Pragma("unroll") for (int m = 0; m < 4; ++m) _Pragma("unroll") for (int n = 0; n < 2; ++n) _Pragma("unroll") for (int k = 0; k < 2; ++k) \
        acc[ai][bj][m][n] = __builtin_amdgcn_mfma_f32_16x16x32_bf16(Bt[n][k], At[m][k], acc[ai][bj][m][n], 0, 0, 0); __builtin_amdgcn_s_setprio(0); } while (0)
#define PG8_WAIT_V(n) asm volatile("s_waitcnt vmcnt(" #n ")" ::: "memory")
#define PG8_WAIT_L(n) asm volatile("s_waitcnt lgkmcnt(" #n ")" ::: "memory")
#define PG8_BAR __builtin_amdgcn_s_barrier()
#define PG8_SCHED __builtin_amdgcn_sched_barrier(0)
    Unit cur, nxt; int ui = 0;
    if (!S.next(0, cur)) return;
    f32x4 acc[2][2][4][2];
#pragma unroll
    for (int a = 0; a < 2; ++a)
#pragma unroll
        for (int b = 0; b < 2; ++b)
#pragma unroll
            for (int m = 0; m < 4; ++m)
#pragma unroll
                for (int n = 0; n < 2; ++n) acc[a][b][m][n] = (f32x4){0.f, 0.f, 0.f, 0.f};
    bf16x8 At[4][2], B0[2][2], B1[2][2];
    const char* cA = (const char*)g.A + (size_t)cur.pm * tstep; const char* cB = (const char*)g.Bt + (size_t)cur.pn * tstep;
    S.a_ready(cur);
    if constexpr (SP2) {
        PG8_STAGE(PG8_SB(0, 0), cB, voffB); PG8_STAGE(PG8_SB(0, 1), cB + hstep, voffB); PG8_STAGE(PG8_SA(0, 0), cA, voffA); PG8_STAGE(PG8_SA(0, 1), cA + hstep, voffA);
        if (wr == 1) PG8_BAR;
        PG8_WAIT_V(2); PG8_BAR;
        PG8_STAGE(PG8_SB(1, 0), cB + kstep, voffB); PG8_STAGE(PG8_SA(1, 0), cA + kstep, voffA); PG8_STAGE(PG8_SB(1, 1), cB + hstep + kstep, voffB);
        PG8_WAIT_V(6); PG8_BAR;
    } else {
        PG8_STAGE(PG8_SB(0, 0), cB, voffB); PG8_STAGE(PG8_SA(0, 0), cA, voffA); PG8_STAGE(PG8_SB(0, 1), cB + hstep, voffB); PG8_STAGE(PG8_SA(0, 1), cA + hstep, voffA);
        if (wr == 1) PG8_BAR;
        PG8_WAIT_V(4); PG8_BAR;
        PG8_STAGE(PG8_SB(1, 0), cB + kstep, voffB); PG8_STAGE(PG8_SA(1, 0), cA + kstep, voffA); PG8_STAGE(PG8_SB(1, 1), cB + hstep + kstep, voffB);
        PG8_WAIT_V(6); PG8_BAR;
    }
    for (;;) {
        const bool has_next = S.next(ui + 1, nxt);
        const char* nA = has_next ? (const char*)g.A + (size_t)nxt.pm * tstep : cA; const char* nB = has_next ? (const char*)g.Bt + (size_t)nxt.pn * tstep : cB;
        for (int t = 0; t < nt; t += 2) {
            const bool last = (t == nt - 2);
            const char* a1 = cA + (size_t)(t + 1) * kstep;
            const char* a2 = last ? nA : cA + (size_t)(t + 2) * kstep; const char* b2 = last ? nB : cB + (size_t)(t + 2) * kstep;
            const char* a3 = a2 + kstep; const char* b3 = b2 + kstep;
            if (last && has_next) S.a_ready(nxt);
            if constexpr (SP2) {
            PG8_LDB(B0, 0, 0); PG8_LDB(B1, 0, 1); PG8_SCHED; PG8_LDA(At, 0, 0); PG8_STAGE(PG8_SA(1, 1), a1 + hstep, voffA);
            PG8_WAIT_V(8); PG8_WAIT_L(0); PG8_BAR; PG8_MMA(0, 0, At, B0); PG8_MMA(0, 1, At, B1); PG8_BAR; PG8_SCHED;
            PG8_LDA(At, 0, 1); PG8_STAGE(PG8_SB(0, 0), b2, voffB); PG8_STAGE(PG8_SB(0, 1), b2 + hstep, voffB); PG8_STAGE(PG8_SA(0, 0), a2, voffA);
            PG8_WAIT_V(8); PG8_WAIT_L(0); PG8_BAR; PG8_MMA(1, 0, At, B0); PG8_MMA(1, 1, At, B1); PG8_BAR; PG8_SCHED;
            PG8_LDB(B0, 1, 0); PG8_LDB(B1, 1, 1); PG8_SCHED; PG8_LDA(At, 1, 0); PG8_STAGE(PG8_SA(0, 1), a2 + hstep, voffA);
            PG8_WAIT_V(8); PG8_WAIT_L(0); PG8_BAR; PG8_MMA(0, 0, At, B0); PG8_MMA(0, 1, At, B1); PG8_BAR; PG8_SCHED;
            PG8_LDA(At, 1, 1); PG8_STAGE(PG8_SB(1, 0), b3, voffB); PG8_STAGE(PG8_SB(1, 1), b3 + hstep, voffB); PG8_STAGE(PG8_SA(1, 0), a3, voffA);
            PG8_WAIT_V(8); PG8_WAIT_L(0); PG8_BAR; PG8_MMA(1, 0, At, B0); PG8_MMA(1, 1, At, B1); PG8_BAR; PG8_SCHED;
            } else {
            PG8_LDB(B0, 0, 0); PG8_SCHED; PG8_LDA(At, 0, 0); PG8_STAGE(PG8_SA(1, 1), a1 + hstep, voffA);
            PG8_WAIT_L(8); PG8_BAR; PG8_WAIT_L(0); PG8_MMA(0, 0, At, B0); PG8_BAR; PG8_SCHED;
            PG8_LDB(B1, 0, 1); PG8_STAGE(PG8_SB(0, 0), b2, voffB);
            PG8_BAR; PG8_WAIT_L(0); PG8_MMA(0, 1, At, B1); PG8_BAR;
            PG8_LDA(At, 0, 1); PG8_STAGE(PG8_SA(0, 0), a2, voffA);
            PG8_BAR; PG8_WAIT_L(0); PG8_MMA(1, 0, At, B0); PG8_BAR; PG8_SCHED;
            PG8_STAGE(PG8_SB(0, 1), b2 + hstep, voffB);
            PG8_WAIT_V(6); PG8_BAR; PG8_MMA(1, 1, At, B1); PG8_BAR;
            PG8_LDB(B0, 1, 0); PG8_SCHED; PG8_LDA(At, 1, 0); PG8_STAGE(PG8_SA(0, 1), a2 + hstep, voffA);
            PG8_WAIT_L(8); PG8_BAR; PG8_WAIT_L(0); PG8_MMA(0, 0, At, B0); PG8_BAR; PG8_SCHED;
            PG8_LDB(B1, 1, 1); PG8_STAGE(PG8_SB(1, 0), b3, voffB);
            PG8_BAR; PG8_WAIT_L(0); PG8_MMA(0, 1, At, B1); PG8_BAR;
            PG8_LDA(At, 1, 1); PG8_STAGE(PG8_SA(1, 0), a3, voffA);
            PG8_BAR; PG8_WAIT_L(0); PG8_MMA(1, 0, At, B0); PG8_BAR; PG8_SCHED;
            PG8_STAGE(PG8_SB(1, 1), b3 + hstep, voffB);
            PG8_WAIT_V(6); PG8_BAR; PG8_MMA(1, 1, At, B1); PG8_BAR;
            }
        }
        if constexpr (ALIGN_EPI) { if (wr == 0) PG8_BAR; }
        if constexpr (!Epi::AFTER_DRAIN) { E(acc, cur, wr, wc, fr, fq); S.done(cur); }
        if (!has_next) break;
#pragma unroll
        for (int a = 0; a < 2; ++a)
#pragma unroll
            for (int b = 0; b < 2; ++b)
#pragma unroll
                for (int m = 0; m < 4; ++m)
#pragma unroll
                    for (int n = 0; n < 2; ++n) acc[a][b][m][n] = (f32x4){0.f, 0.f, 0.f, 0.f};
        cur = nxt; cA = nA; cB = nB; ++ui;
        if constexpr (ALIGN_EPI) { if (wr == 1) PG8_BAR; }
    }
    PG8_WAIT_V(0);
    if constexpr (!ALIGN_EPI) { if (wr == 0) PG8_BAR; }
    PG8_BAR;
    if constexpr (Epi::AFTER_DRAIN) { E.fused(acc, cur, wr, wc, fr, fq, lds, wid, lane); S.done(cur); }
#undef PG8_SA
#undef PG8_SB
#undef PG8_STAGE
#undef PG8_LDA
#undef PG8_LDB
#undef PG8_MMA
#undef PG8_WAIT_V
#undef PG8_WAIT_L
#undef PG8_BAR
#undef PG8_SCHED
}
}
namespace pg8 {
__device__ __forceinline__ float sigm(float x) { return __builtin_amdgcn_rcpf(1.0f + __expf(-x)); }
__device__ __forceinline__ float gelu_tanh(float x) { return x * sigm(1.5957691216f * (x + 0.044715f * x * x * x)); }

__device__ __forceinline__ float row_rinv(const float* ssq, int row) {
    const f32x4* p = (const f32x4*)(ssq + (size_t)row * 16); const f32x4 a = p[0], b = p[1], c = p[2], d = p[3];
    const float s = (((a[0] + a[1]) + (a[2] + a[3])) + ((b[0] + b[1]) + (b[2] + b[3]))) + (((c[0] + c[1]) + (c[2] + c[3])) + ((d[0] + d[1]) + (d[2] + d[3])));
    return rsqrtf(s * (1.0f / 1024.0f) + 1e-6f);
}
constexpr int RINV_LDS_OFF = 131072 + 2048;
struct RowRinv8 {
    float r[2][4];
    __device__ __forceinline__ void load(const float* ssq, int row0, int fq, int pm, PG8_LAS unsigned char* lds) {
        PG8_LAS f32x4* slot = (PG8_LAS f32x4*)(lds + RINV_LDS_OFF + (int)threadIdx.x * 48);
        const f32x4 t = slot[2];
        if (__float_as_int(t[0]) == pm + 1) { const f32x4 a = slot[0], b = slot[1]; r[0][0] = a[0]; r[0][1] = a[1]; r[0][2] = a[2]; r[0][3] = a[3]; r[1][0] = b[0]; r[1][1] = b[1]; r[1][2] = b[2]; r[1][3] = b[3]; }
        else {
            f32x4 p[2][4];
#pragma unroll
            for (int ai = 0; ai < 2; ++ai)
#pragma unroll
                for (int m = 0; m < 4; ++m) p[ai][m] = *(const f32x4*)(ssq + (size_t)(row0 + ai * HALF + m * 16) * 16 + 4 * fq);
#pragma unroll
            for (int ai = 0; ai < 2; ++ai)
#pragma unroll
                for (int m = 0; m < 4; ++m) { float s = (p[ai][m][0] + p[ai][m][1]) + (p[ai][m][2] + p[ai][m][3]); s += __shfl_xor(s, 16); s += __shfl_xor(s, 32); r[ai][m] = rsqrtf(s * (1.0f / 1024.0f) + 1e-6f); }
            slot[0] = (f32x4){r[0][0], r[0][1], r[0][2], r[0][3]}; slot[1] = (f32x4){r[1][0], r[1][1], r[1][2], r[1][3]}; slot[2] = (f32x4){__int_as_float(pm + 1), 0.f, 0.f, 0.f};
        }
    }
    __device__ __forceinline__ float get(int ai, int m) const { return r[ai][m]; }
};
struct EpiSwiGLU {
    static constexpr bool PERM = true, AFTER_DRAIN = false;
    bf16_t* O; int ldc; const float* ssq; PG8_LAS unsigned char* lds;
    __device__ __forceinline__ void operator()(const f32x4 (&acc)[2][2][4][2], const Unit& u, int wr, int wc, int fr, int fq) const {
        const int row0 = u.pm * BM + wr * 64 + fr, col0 = u.pn * HALF + wc * 32 + 8 * fq;
        RowRinv8 rr; rr.load(ssq, row0, fq, u.pm, lds);
#pragma unroll
        for (int ai = 0; ai < 2; ++ai)
#pragma unroll
            for (int m = 0; m < 4; ++m) {
                bf16_t* rowp = O + (size_t)(row0 + ai * HALF + m * 16) * ldc + col0;
                const float ri = rr.get(ai, m);
                float r[8];
#pragma unroll
                for (int n = 0; n < 2; ++n)
#pragma unroll
                    for (int j = 0; j < 4; ++j) { const float g = acc[ai][0][m][n][j] * ri, up = acc[ai][1][m][n][j] * ri; r[n * 4 + j] = g * sigm(g) * up; }
                u32x4 w; w.x = cvt_pk_bf16(r[0], r[1]); w.y = cvt_pk_bf16(r[2], r[3]); w.z = cvt_pk_bf16(r[4], r[5]); w.w = cvt_pk_bf16(r[6], r[7]);
                *(u32x4*)rowp = w;
            }
    }
};

struct EpiResid {
    static constexpr bool PERM = false, AFTER_DRAIN = false;
    const float* base32; float* out32; bf16_t* xb; float* ssq; int ldc; float scale;
    typedef unsigned u32x2_ __attribute__((ext_vector_type(2)));
    static __device__ __forceinline__ f32x4 unpack4(u32x2_ t) { return (f32x4){__uint_as_float(t.x << 16), __uint_as_float(t.x & 0xffff0000u), __uint_as_float(t.y << 16), __uint_as_float(t.y & 0xffff0000u)}; }
    __device__ __forceinline__ void operator()(const f32x4 (&acc)[2][2][4][2], const Unit& u, int wr, int wc, int fr, int fq) const {
        const int row0 = u.pm * BM + wr * 64 + fr, col0 = u.pn * BM + wc * 32 + 4 * fq;
        if (base32) {
#pragma unroll
            for (int ai = 0; ai < 2; ++ai)
#pragma unroll
                for (int m = 0; m < 4; ++m) {
                    const int row = row0 + ai * HALF + m * 16; const size_t off = (size_t)row * ldc + col0; float ss = 0.f;
#pragma unroll
                    for (int bj = 0; bj < 2; ++bj)
#pragma unroll
                        for (int n = 0; n < 2; ++n) { const size_t o = off + bj * HALF + n * 16; const f32x4 b = *(const f32x4*)(base32 + o);
                            f32x4 v = b + acc[ai][bj][m][n] * scale;
                            u32x2_ w; w.x = cvt_pk_bf16(v[0], v[1]); w.y = cvt_pk_bf16(v[2], v[3]); *(u32x2_*)(xb + o) = w;
                            if (out32) *(f32x4*)(out32 + o) = v; else v = unpack4(w);
                            ss += (v[0] * v[0] + v[1] * v[1]) + (v[2] * v[2] + v[3] * v[3]); }
                    ss += __shfl_xor(ss, 16); ss += __shfl_xor(ss, 32);
                    if (fq == 0) ssq[(size_t)row * 16 + 4 * u.pn + wc] = ss;
                    if (m & 1) asm volatile("" ::: "memory");
                }
        } else {
#pragma unroll
            for (int ai = 0; ai < 2; ++ai) {
                u32x2_ bb[4][2][2];
#pragma unroll
                for (int m = 0; m < 4; ++m)
#pragma unroll
                    for (int bj = 0; bj < 2; ++bj)
#pragma unroll
                        for (int n = 0; n < 2; ++n) bb[m][bj][n] = *(const u32x2_*)(xb + (size_t)(row0 + ai * HALF + m * 16) * ldc + col0 + bj * HALF + n * 16);
#pragma unroll
                for (int m = 0; m < 4; ++m) {
                    const int row = row0 + ai * HALF + m * 16; const size_t off = (size_t)row * ldc + col0; float ss = 0.f;
#pragma unroll
                    for (int bj = 0; bj < 2; ++bj)
#pragma unroll
                        for (int n = 0; n < 2; ++n) { const size_t o = off + bj * HALF + n * 16;
                            f32x4 v = unpack4(bb[m][bj][n]) + acc[ai][bj][m][n] * scale;
                            u32x2_ w; w.x = cvt_pk_bf16(v[0], v[1]); w.y = cvt_pk_bf16(v[2], v[3]); *(u32x2_*)(xb + o) = w;
                            if (out32) *(f32x4*)(out32 + o) = v; else v = unpack4(w);
                            ss += (v[0] * v[0] + v[1] * v[1]) + (v[2] * v[2] + v[3] * v[3]); }
                    ss += __shfl_xor(ss, 16); ss += __shfl_xor(ss, 32);
                    if (fq == 0) ssq[(size_t)row * 16 + 4 * u.pn + wc] = ss;
                }
                asm volatile("" ::: "memory");
            }
        }
    }
};

struct EpiMix {
    static constexpr bool PERM = true, AFTER_DRAIN = false;
    unsigned char* R; const float* lb; const float* ssq; PG8_LAS unsigned char* lds;
    __device__ __forceinline__ void operator()(const f32x4 (&acc)[2][2][4][2], const Unit& u, int wr, int wc, int fr, int fq) const {
        const int seg = u.pn >> 1;
        const int colb = (u.pn & 1) * 256 + wc * 32 + 8 * fq, row0 = u.pm * BM + wr * 64 + fr;
        RowRinv8 rr; rr.load(ssq, row0, fq, u.pm, lds);
        if (seg <= 1) {
            float* LF = (float*)(R + (seg == 0 ? (size_t)0 : ((size_t)64 << 20)));
#pragma unroll
            for (int bj = 0; bj < 2; ++bj) {
#pragma unroll
                for (int ai = 0; ai < 2; ++ai)
#pragma unroll
                    for (int m = 0; m < 4; ++m) {
                        float* rowp = LF + (size_t)(row0 + ai * HALF + m * 16) * 512 + colb + bj * HALF;
                        const float ri = rr.get(ai, m);
                        f32x4 o0, o1;
                        o0 = acc[ai][bj][m][0] * ri; o1 = acc[ai][bj][m][1] * ri;
                        *(f32x4*)rowp = o0; *(f32x4*)(rowp + 4) = o1;
                    }
            }
        } else {
            const size_t boff = (size_t)(64 + 32 * seg) << 20;
            bf16_t* B = (bf16_t*)(R + boff);
#pragma unroll
            for (int ai = 0; ai < 2; ++ai)
#pragma unroll
                for (int m = 0; m < 4; ++m) {
                    const float ri = rr.get(ai, m);
#pragma unroll
                    for (int bj = 0; bj < 2; ++bj) {
                        bf16_t* rowp = B + (size_t)(row0 + ai * HALF + m * 16) * 512 + colb + bj * HALF;
                        float r[8];
#pragma unroll
                        for (int n = 0; n < 2; ++n)
#pragma unroll
                            for (int j = 0; j < 4; ++j) { const float x = acc[ai][bj][m][n][j] * ri; r[n * 4 + j] = x; }
                        u32x4 w; w.x = cvt_pk_bf16(r[0], r[1]); w.y = cvt_pk_bf16(r[2], r[3]); w.z = cvt_pk_bf16(r[4], r[5]); w.w = cvt_pk_bf16(r[6], r[7]);
                        *(u32x4*)rowp = w;
                    } }
        }
    }
};
}
constexpr int NB = 4, SEQ = 8192, D = 1024, FF = 2816, DIN = 3072, AW = 512, NLAYER = 2;
constexpr int M = NB * SEQ;
constexpr float EPS = 1e-6f;
#define LAS __attribute__((address_space(3)))
typedef pg8::bf16_t bf16_t;
typedef float f32x4 __attribute__((ext_vector_type(4)));
typedef float f32x2 __attribute__((ext_vector_type(2)));
typedef unsigned u32x4 __attribute__((ext_vector_type(4)));
typedef unsigned u32x2 __attribute__((ext_vector_type(2)));
constexpr size_t MiB = 1u << 20;
constexpr size_t WL_GU1 = 0, WL_DN1 = 11 * MiB, WL_WIN = WL_DN1 + 11 * MiB / 2, WL_WOUT = WL_WIN + 6 * MiB, WL_GU2 = WL_WOUT + 2 * MiB, WL_DN2 = WL_GU2 + 11 * MiB, WL_STRIDE = 41 * MiB;
static_assert(WL_DN2 + 11 * MiB / 2 == WL_STRIDE, "weights");
constexpr size_t WS_BAR = 82 * MiB + 65536, BAR_BYTES = 16384;
constexpr size_t WS_LBS = 82 * MiB, WS_DBUF = 83 * MiB, WS_SSQ = 84 * MiB;
constexpr size_t WS_XB = 86 * MiB;
constexpr size_t WS_R = 150 * MiB;
constexpr size_t R_Q = 0, R_LF = 64 * MiB, R_V = 128 * MiB, R_G = 160 * MiB, R_U = 192 * MiB, R_VV = 224 * MiB, R_O = 256 * MiB;
constexpr size_t WS_END = WS_R + R_O + 64 * MiB;
constexpr int LDS_BYTES = 131072 + 2048 + 512 * 48;

__device__ __forceinline__ float bf2f(unsigned h) { return __uint_as_float(h << 16); }
__device__ __forceinline__ float wave_sum(float v) {
#pragma unroll
    for (int o = 1; o < 64; o <<= 1) v += __shfl_xor(v, o);
    return v;
}
#define LDS_WAIT() asm volatile("s_waitcnt lgkmcnt(0)" ::: "memory")

__device__ __forceinline__ void transpose_item(const float* W, int K, int N, bf16_t* WT, int k0, int n0, int drow0, const float* gain, LAS float* scr, int lane) {
    f32x4 v[8]; float gk[8];
#pragma unroll
    for (int i = 0; i < 8; ++i) { const int kk = 8 * i + (lane >> 3); v[i] = *(const f32x4*)(W + (size_t)(k0 + kk) * N + n0 + (lane & 7) * 4); gk[i] = gain ? gain[k0 + kk] : 1.0f; }
#pragma unroll
    for (int i = 0; i < 8; ++i) { const int kk = 8 * i + (lane >> 3); LAS float* d = scr + kk * 33 + (lane & 7) * 4; d[0] = v[i][0] * gk[i]; d[1] = v[i][1] * gk[i]; d[2] = v[i][2] * gk[i]; d[3] = v[i][3] * gk[i]; }
    LDS_WAIT(); asm volatile("" ::: "memory");
    const int c = lane & 7;
#pragma unroll
    for (int j = 0; j < 4; ++j) { const int n = (lane >> 3) + 8 * j; const LAS float* s = scr + (8 * c) * 33 + n;
        u32x4 o; o.x = pg8::cvt_pk_bf16(s[0 * 33], s[1 * 33]); o.y = pg8::cvt_pk_bf16(s[2 * 33], s[3 * 33]); o.z = pg8::cvt_pk_bf16(s[4 * 33], s[5 * 33]); o.w = pg8::cvt_pk_bf16(s[6 * 33], s[7 * 33]);
        *(u32x4*)(WT + (size_t)(drow0 + n) * K + k0 + 8 * c) = o; }
    LDS_WAIT(); asm volatile("" ::: "memory");
}

__device__ __forceinline__ void row_to_xb(const float* xrow, bf16_t* orow, float* ssqrow, int lane) {
    const f32x4* xr = (const f32x4*)xrow + lane;
    f32x4 v[4]; float s = 0.f;
#pragma unroll
    for (int j = 0; j < 4; ++j) { v[j] = xr[64 * j]; s += (v[j].x * v[j].x + v[j].y * v[j].y) + (v[j].z * v[j].z + v[j].w * v[j].w); }
    s = wave_sum(s);
    u32x2* o8 = (u32x2*)orow + lane;
#pragma unroll
    for (int j = 0; j < 4; ++j) { u32x2 o; o.x = pg8::cvt_pk_bf16(v[j].x, v[j].y); o.y = pg8::cvt_pk_bf16(v[j].z, v[j].w); o8[64 * j] = o; }
    if (lane < 4) ((f32x4*)ssqrow)[lane] = (f32x4){lane == 0 ? s : 0.f, 0.f, 0.f, 0.f};
}
__device__ __forceinline__ void final_norm_row(const bf16_t* xrow, float* orow, const float* g, const float* ssq, int row, int lane) {
    const float rinv = pg8::row_rinv(ssq, row);
    const u32x2* xr = (const u32x2*)xrow + lane; const f32x4* gr = (const f32x4*)g + lane; f32x4* o = (f32x4*)orow + lane;
    u32x2 v[4];
#pragma unroll
    for (int j = 0; j < 4; ++j) v[j] = xr[64 * j];
#pragma unroll
    for (int j = 0; j < 4; ++j) { const f32x4 x = (f32x4){bf2f(v[j].x & 0xffff), bf2f(v[j].x >> 16), bf2f(v[j].y & 0xffff), bf2f(v[j].y >> 16)}; o[64 * j] = x * rinv * gr[64 * j]; }
}

#define XB_TMO      128
#define XB_XCNT(j)  (256  + 64 * (j))
#define XB_XSUB(j)  (1280 + 64 * (j))
#define XB_XGEN(j)  (2304 + 64 * (j))
#define XB_TOP      3328
#define XB_TOPGEN   3392
#define XCD_BAR_WORDS 3456
#define XB_SPIN_CAP (1u << 18)

__device__ __forceinline__ unsigned xb_ld(unsigned* p)              { return __hip_atomic_load(p, __ATOMIC_RELAXED, __HIP_MEMORY_SCOPE_AGENT); }
__device__ __forceinline__ unsigned xb_add(unsigned* p, unsigned v) { return __hip_atomic_fetch_add(p, v, __ATOMIC_RELAXED, __HIP_MEMORY_SCOPE_AGENT); }
__device__ __forceinline__ unsigned xb_xcc_id() { return (unsigned)__builtin_amdgcn_s_getreg((3 << 11) | 20) & 0xFu; }
#define XB_SPIN(cond, bar) do { unsigned _sp = 0; while (cond) { __builtin_amdgcn_s_sleep(1); \
    if ((++_sp & 255u) == 0u) { if (xb_ld(&(bar)[XB_TMO])) break; if (_sp > XB_SPIN_CAP) { atomicAdd(&(bar)[XB_TMO], 1u); break; } } } } while (0)

struct XcdBarrier {
    unsigned* bar; unsigned x;
    volatile LAS unsigned* st;
};

__device__ __forceinline__ XcdBarrier xcd_barrier_post(unsigned* bar, volatile LAS unsigned* st) {
    XcdBarrier b; b.bar = bar; b.x = xb_xcc_id(); b.st = st;
    if (threadIdx.x == 0) (void)xb_add(&bar[XB_XCNT(b.x)], 1u);
    return b;
}
__device__ __forceinline__ void xcd_barrier_complete(unsigned* bar, unsigned x, unsigned& nloc, unsigned& nx) {
    const unsigned G = gridDim.x * gridDim.y * gridDim.z;
    unsigned sum, cnt, mine, sp = 0u;
    for (;;) {
        sum = 0u; cnt = 0u; mine = 0u;
#pragma unroll
        for (unsigned j = 0; j < 16; ++j) { const unsigned c = xb_ld(&bar[XB_XCNT(j)]); sum += c; cnt += (c > 0u) ? 1u : 0u; mine = (j == x) ? c : mine; }
        if (sum == G) break;
        __builtin_amdgcn_s_sleep(1);
        if ((++sp & 255u) == 0u) { if (xb_ld(&bar[XB_TMO])) break; if (sp > XB_SPIN_CAP) { atomicAdd(&bar[XB_TMO], 1u); break; } }
    }
    nloc = mine > 0u ? mine : 1u; nx = cnt > 0u ? cnt : 1u;
}

__device__ __forceinline__ void xcd_barrier(const XcdBarrier& b) {
    asm volatile("s_waitcnt vmcnt(0)" ::: "memory");
    __syncthreads();
    if (threadIdx.x == 0) {
        unsigned* bar = b.bar;
        __builtin_amdgcn_s_waitcnt(0);
        unsigned nloc = b.st[0], nx = b.st[1];
        if (nloc == 0u) { xcd_barrier_complete(bar, b.x, nloc, nx); b.st[0] = nloc; b.st[1] = nx; }
        const unsigned old = xb_add(&bar[XB_XSUB(b.x)], 1u);
        const unsigned gen = old / nloc;
        if (old + 1u == (gen + 1u) * nloc) {
            __builtin_amdgcn_fence(__ATOMIC_RELEASE, "agent");
            asm volatile("s_waitcnt vmcnt(0)" ::: "memory");
            const unsigned og = xb_add(&bar[XB_TOP], 1u);
            const unsigned tg = og / nx;
            if (og + 1u == (tg + 1u) * nx) xb_add(&bar[XB_TOPGEN], 1u);
            else XB_SPIN(xb_ld(&bar[XB_TOPGEN]) == tg, bar);
            __builtin_amdgcn_fence(__ATOMIC_ACQUIRE, "agent");
            xb_add(&bar[XB_XGEN(b.x)], 1u);
            asm volatile("s_waitcnt vmcnt(0)" ::: "memory");
        } else {
            XB_SPIN(xb_ld(&bar[XB_XGEN(b.x)]) == gen, bar);
            __builtin_amdgcn_fence(__ATOMIC_ACQUIRE, "agent");
            asm volatile("s_waitcnt vmcnt(0)" ::: "memory");
        }
    }
    __syncthreads();
}

#ifndef PROBE_PREP
#define PROBE_PREP 0
#endif
#ifndef PROBE_SYNCS
#define PROBE_SYNCS 0
#endif
#ifdef PROBE_DUP_S
constexpr int NPHASE = 2 + PROBE_PREP + PROBE_SYNCS + 10 * NLAYER;
#else
constexpr int NPHASE = 2 + PROBE_PREP + PROBE_SYNCS + 9 * NLAYER;
#endif
struct Params { const float* in[19]; float* out; unsigned char* ws; int ph_lo, ph_hi; };
typedef const __attribute__((address_space(4))) unsigned long long* kaptr_t;
__device__ __forceinline__ unsigned long long karg(int i) { kaptr_t ka = (kaptr_t)__builtin_amdgcn_kernarg_segment_ptr(); asm volatile("" : "+s"(ka)); return ka[i]; }
__device__ __forceinline__ const float* kin(int i) { return (const float*)karg(i); }
__device__ __forceinline__ float* kout() { return (float*)karg(19); }
__device__ __forceinline__ unsigned char* kws() { return (unsigned char*)karg(20); }


typedef short bf16x8 __attribute__((ext_vector_type(8)));
#define MFMA16(a, b, c) __builtin_amdgcn_mfma_f32_16x16x32_bf16(a, b, c, 0, 0, 0)
typedef __bf16 bf16v2_t __attribute__((ext_vector_type(2)));
__device__ __forceinline__ unsigned cvt2(float lo, float hi) { bf16v2_t r = __builtin_convertvector((f32x2){lo, hi}, bf16v2_t); return __builtin_bit_cast(unsigned, r); }
#define LDFRAG(base, row, stride_b, kofs) (*(const LAS bf16x8*)((base) + (row) * (stride_b) + (kofs) * 2))
constexpr int KT_STRIDE = 144;
constexpr int QK_STRIDE = 272;

__device__ __forceinline__ float sigm_(float x) { return __builtin_amdgcn_rcpf(1.0f + __expf(-x)); }
__device__ __forceinline__ float gelu_(float x) { return x * sigm_(1.5957691216f * (x + 0.044715f * x * x * x)); }
#define HG_LOADZ(dst, LFp, r0_) do { const float* lfp_ = (LFp) + (size_t)((r0_) + seg * 16) * AW + h * 128 + k; \
    _Pragma("unroll") for (int i = 0; i < 16; ++i) (dst)[i] = lfp_[(size_t)i * AW]; } while (0)
#define HG_CUMSUM(tot) \
    float a[16]; { \
    { const float lb_ = lbp[h * 128 + k]; _Pragma("unroll") for (int i = 0; i < 16; ++i) lf[i] = __logf(fmaxf(lb_ + (1.0f - lb_) * sigm_(lf[i]), 1e-20f)); } \
    float c = 0.f; _Pragma("unroll") for (int i = 0; i < 16; ++i) { c += lf[i]; a[i] = c; } \
    (tot)[seg * 128 + k] = c; } \
    __syncthreads(); \
    const float t0_ = (tot)[k], t1_ = (tot)[128 + k], t2_ = (tot)[256 + k], t3_ = (tot)[384 + k]; \
    const float pre_ = seg == 0 ? 0.f : (seg == 1 ? t0_ : (seg == 2 ? t0_ + t1_ : t0_ + t1_ + t2_)); \
    const float a_last = (t0_ + t1_) + (t2_ + t3_), a_ref = t0_ + t1_; \
    _Pragma("unroll") for (int i = 0; i < 16; ++i) a[i] += pre_;

__device__ __forceinline__ void load_v(u32x4 (&w)[2], const bf16_t* Vp, int tid) {
#pragma unroll
    for (int i = 0; i < 2; ++i) { const int idx = tid + 512 * i, s = idx & 63, vc = idx >> 6; w[i] = *(const u32x4*)(Vp + (size_t)s * AW + vc * 8); }
}
__device__ __forceinline__ void store_vt(LAS unsigned char* vt, const u32x4 (&w)[2], int tid) {
#pragma unroll
    for (int i = 0; i < 2; ++i) { const int idx = tid + 512 * i, s = idx & 63, vc = idx >> 6;
        LAS unsigned short* d = (LAS unsigned short*)(vt + (vc * 8) * KT_STRIDE + s * 2);
        d[0 * (KT_STRIDE / 2)] = (unsigned short)(w[i].x & 0xffff); d[1 * (KT_STRIDE / 2)] = (unsigned short)(w[i].x >> 16);
        d[2 * (KT_STRIDE / 2)] = (unsigned short)(w[i].y & 0xffff); d[3 * (KT_STRIDE / 2)] = (unsigned short)(w[i].y >> 16);
        d[4 * (KT_STRIDE / 2)] = (unsigned short)(w[i].z & 0xffff); d[5 * (KT_STRIDE / 2)] = (unsigned short)(w[i].z >> 16);
        d[6 * (KT_STRIDE / 2)] = (unsigned short)(w[i].w & 0xffff); d[7 * (KT_STRIDE / 2)] = (unsigned short)(w[i].w >> 16); }
}

__device__ __forceinline__ void hgrn_pass1_all(LAS unsigned char* lds, const unsigned char* R, bf16_t* ST, float* DBUF, const float* lbp, int u0, int ustep, int tid) {
    const int k = tid & 127, seg = tid >> 7, lane = tid & 63, w = __builtin_amdgcn_readfirstlane(tid >> 6), fr = lane & 15, fq = lane >> 4;
    LAS unsigned char* kdt = lds; LAS unsigned char* vt = lds + 18432; LAS float* tot = (LAS float*)(lds + 36864);
    const float* LF = (const float*)(R + R_LF); const bf16_t* V = (const bf16_t*)(R + R_V);
    float zn[16]; u32x4 vwn[2];
    if (u0 < 2048) { const int bh = u0 >> 7, n = u0 & 127, b = bh >> 2, h = bh & 3; const size_t r0 = (size_t)b * SEQ + n * 64; HG_LOADZ(zn, LF, r0); load_v(vwn, V + r0 * AW + h * 128, tid); }
    for (int unit = u0; unit < 2048; unit += ustep) {
        const int bh = unit >> 7, n = unit & 127, b = bh >> 2, h = bh & 3;
        float lf[16]; u32x4 vw[2];
#pragma unroll
        for (int i = 0; i < 16; ++i) lf[i] = zn[i];
        vw[0] = vwn[0]; vw[1] = vwn[1];
        __syncthreads();
        { const int un = unit + ustep; if (un < 2048) { const int bh2 = un >> 7, n2 = un & 127, b2 = bh2 >> 2, h2 = bh2 & 3; const size_t r2 = (size_t)b2 * SEQ + n2 * 64;
            { const int h = h2; HG_LOADZ(zn, LF, r2); } load_v(vwn, V + r2 * AW + h2 * 128, tid); } }
        HG_CUMSUM(tot)
        {   unsigned pk[8];
#pragma unroll
            for (int i = 0; i < 8; ++i) { const float k0 = (1.0f - __expf(lf[2 * i])) * __expf(a_last - a[2 * i]), k1 = (1.0f - __expf(lf[2 * i + 1])) * __expf(a_last - a[2 * i + 1]); pk[i] = cvt2(k0, k1); }
            LAS u32x4* d = (LAS u32x4*)(kdt + k * KT_STRIDE + seg * 32);
            d[0] = (u32x4){pk[0], pk[1], pk[2], pk[3]}; d[1] = (u32x4){pk[4], pk[5], pk[6], pk[7]};
            if (seg == 0) DBUF[(size_t)unit * 128 + k] = __expf(a_last); }
        store_vt(vt, vw, tid);
        __syncthreads();
        bf16x8 bV[2];
#pragma unroll
        for (int ks = 0; ks < 2; ++ks) bV[ks] = LDFRAG(vt, 16 * w + fr, KT_STRIDE, 32 * ks + 8 * fq);
        bf16_t* up = ST + (size_t)unit * 16384 + (size_t)(16 * w + fr) * 128 + 4 * fq;
#pragma unroll
        for (int kt = 0; kt < 8; ++kt) { f32x4 acc = (f32x4){0.f, 0.f, 0.f, 0.f};
#pragma unroll
            for (int ks = 0; ks < 2; ++ks) acc = MFMA16(LDFRAG(kdt, 16 * kt + fr, KT_STRIDE, 32 * ks + 8 * fq), bV[ks], acc);
            u32x2 o; o.x = cvt2(acc[0], acc[1]); o.y = cvt2(acc[2], acc[3]);
            *(u32x2*)(up + 16 * kt) = o; }
    }
}

__device__ __forceinline__ void hgrn_scan(unsigned* STw, const float* DBUF, int item, int tid) {
    const int bh = item >> 4, e2 = (item & 15) * 512 + tid;
    unsigned* Up = STw + (size_t)bh * 128 * 8192 + e2;
    const float* dp = DBUF + (size_t)bh * 128 * 128 + ((2 * e2) & 127);
    float S0 = 0.f, S1 = 0.f;
    for (int n0 = 0; n0 < 128; n0 += 16) {
        unsigned u[16]; f32x2 d[16];
#pragma unroll
        for (int i = 0; i < 16; ++i) { u[i] = Up[(size_t)(n0 + i) * 8192]; d[i] = *(const f32x2*)(dp + (n0 + i) * 128); }
#pragma unroll
        for (int i = 0; i < 16; ++i) { Up[(size_t)(n0 + i) * 8192] = cvt2(S0, S1); S0 = d[i].x * S0 + bf2f(u[i] & 0xffff); S1 = d[i].y * S1 + bf2f(u[i] >> 16); }
    }
}

__device__ __forceinline__ unsigned bf_hi(float x) { return cvt2(x, 0.f) & 0xffffu; }
__device__ __forceinline__ void hgrn_pass3_all(LAS unsigned char* lds, const unsigned char* R, const bf16_t* ST, bf16_t* O, const float* ng, const float* lbp, int u0, int ustep, int tid) {
    const int k = tid & 127, seg = tid >> 7, lane = tid & 63, w = __builtin_amdgcn_readfirstlane(tid >> 6), fr = lane & 15, fq = lane >> 4;
    LAS unsigned char* qmh = lds; LAS unsigned char* qml = lds + 17408; LAS unsigned char* kmh = lds + 34816; LAS unsigned char* kml = lds + 52224; LAS unsigned char* qs = lds + 69632;
    LAS unsigned char* vt = lds + 87040; LAS unsigned char* pp = lds + 105472; LAS float* tot = (LAS float*)(lds + 114688); LAS float* red = (LAS float*)(lds + 116736);
    const float* Q = (const float*)(R + R_Q); const float* LF = (const float*)(R + R_LF); const bf16_t* V = (const bf16_t*)(R + R_V); const bf16_t* GB = (const bf16_t*)(R + R_G);
    const int tt = w & 3, vh = w >> 2;
    float zn[16], qn[16]; u32x4 vwn[2];
    if (u0 < 2048) { const int bh = u0 >> 7, n = u0 & 127, b = bh >> 2, h = bh & 3; const size_t r0 = (size_t)b * SEQ + n * 64; HG_LOADZ(zn, LF, r0); HG_LOADZ(qn, Q, r0); load_v(vwn, V + r0 * AW + h * 128, tid); }
    for (int unit = u0; unit < 2048; unit += ustep) {
    const int bh = unit >> 7, n = unit & 127, b = bh >> 2, h = bh & 3; const size_t r0 = (size_t)b * SEQ + n * 64;
    bf16x8 aS[4][4];
    { const bf16_t* sp = ST + (size_t)unit * 16384 + (size_t)(64 * vh + fr) * 128 + 8 * fq;
#pragma unroll
      for (int j = 0; j < 4; ++j)
#pragma unroll
        for (int ks = 0; ks < 4; ++ks) aS[j][ks] = *(const bf16x8*)(sp + (size_t)(16 * j) * 128 + 32 * ks); }
    u32x4 vw[2]; vw[0] = vwn[0]; vw[1] = vwn[1];
    u32x2 ggv[4]; f32x4 g4v[4];
#pragma unroll
    for (int j = 0; j < 4; ++j) { const int v0 = 16 * (4 * vh + j) + 4 * fq; ggv[j] = *(const u32x2*)(GB + (r0 + 16 * tt + fr) * AW + h * 128 + v0); g4v[j] = *(const f32x4*)(ng + h * 128 + v0); }
    float qv[16], lf[16];
#pragma unroll
    for (int i = 0; i < 16; ++i) { qv[i] = qn[i]; lf[i] = zn[i]; }
    __syncthreads();
    { const int un = unit + ustep; if (un < 2048) { const int bh2 = un >> 7, n2 = un & 127, b2 = bh2 >> 2, h2 = bh2 & 3; const size_t r2 = (size_t)b2 * SEQ + n2 * 64;
        { const int h = h2; HG_LOADZ(zn, LF, r2); HG_LOADZ(qn, Q, r2); } load_v(vwn, V + r2 * AW + h2 * 128, tid); } }
    HG_CUMSUM(tot)
#pragma unroll
    for (int i = 0; i < 16; ++i) { const int t = seg * 16 + i; const float kk = 1.0f - __expf(lf[i]);
        const float qmv = qv[i] * __expf(a[i] - a_ref), kmv = kk * __expf(a_ref - a[i]);
        const unsigned qh = bf_hi(qmv), kh = bf_hi(kmv);
        *(LAS unsigned short*)(qmh + t * QK_STRIDE + k * 2) = (unsigned short)qh;
        *(LAS unsigned short*)(qml + t * QK_STRIDE + k * 2) = (unsigned short)bf_hi(qmv - bf2f(qh));
        *(LAS unsigned short*)(kmh + t * QK_STRIDE + k * 2) = (unsigned short)kh;
        *(LAS unsigned short*)(kml + t * QK_STRIDE + k * 2) = (unsigned short)bf_hi(kmv - bf2f(kh));
        *(LAS unsigned short*)(qs + t * QK_STRIDE + k * 2) = (unsigned short)bf_hi(qv[i] * __expf(a[i])); }
    store_vt(vt, vw, tid);
    __syncthreads();
#pragma unroll
    for (int i2 = 0; i2 < 2; ++i2) { const int st = 2 * vh + i2; f32x4 acc = (f32x4){0.f, 0.f, 0.f, 0.f};
        if (st <= tt) {
#pragma unroll
            for (int ks = 0; ks < 4; ++ks) { const bf16x8 kH = LDFRAG(kmh, 16 * st + fr, QK_STRIDE, 32 * ks + 8 * fq), kL = LDFRAG(kml, 16 * st + fr, QK_STRIDE, 32 * ks + 8 * fq);
                const bf16x8 qH = LDFRAG(qmh, 16 * tt + fr, QK_STRIDE, 32 * ks + 8 * fq), qL = LDFRAG(qml, 16 * tt + fr, QK_STRIDE, 32 * ks + 8 * fq);
                acc = MFMA16(kL, qH, acc); acc = MFMA16(kH, qL, acc); acc = MFMA16(kH, qH, acc); }
            const int t = 16 * tt + fr, s0 = 16 * st + 4 * fq;
#pragma unroll
            for (int e = 0; e < 4; ++e) acc[e] = (s0 + e <= t) ? acc[e] : 0.f; }
        u32x2 o; o.x = cvt2(acc[0], acc[1]); o.y = cvt2(acc[2], acc[3]);
        *(LAS u32x2*)(pp + (16 * tt + fr) * KT_STRIDE + (16 * st + 4 * fq) * 2) = o; }
    __syncthreads();
    f32x4 o4[4];
    { bf16x8 bP[2], bQ[4];
#pragma unroll
      for (int ks = 0; ks < 2; ++ks) bP[ks] = LDFRAG(pp, 16 * tt + fr, KT_STRIDE, 32 * ks + 8 * fq);
#pragma unroll
      for (int ks = 0; ks < 4; ++ks) bQ[ks] = LDFRAG(qs, 16 * tt + fr, QK_STRIDE, 32 * ks + 8 * fq);
#pragma unroll
      for (int j = 0; j < 4; ++j) { f32x4 acc = (f32x4){0.f, 0.f, 0.f, 0.f};
#pragma unroll
        for (int ks = 0; ks < 2; ++ks) acc = MFMA16(LDFRAG(vt, 16 * (4 * vh + j) + fr, KT_STRIDE, 32 * ks + 8 * fq), bP[ks], acc);
#pragma unroll
        for (int ks = 0; ks < 4; ++ks) acc = MFMA16(aS[j][ks], bQ[ks], acc);
        o4[j] = acc; } }
    float ss = 0.f;
#pragma unroll
    for (int j = 0; j < 4; ++j) ss += (o4[j][0] * o4[j][0] + o4[j][1] * o4[j][1]) + (o4[j][2] * o4[j][2] + o4[j][3] * o4[j][3]);
    ss += __shfl_xor(ss, 16); ss += __shfl_xor(ss, 32);
    if (fq == 0) red[vh * 64 + 16 * tt + fr] = ss;
    __syncthreads();
    const float rinv = rsqrtf((red[16 * tt + fr] + red[64 + 16 * tt + fr]) * (1.f / 128.f) + EPS);
    const size_t row = r0 + 16 * tt + fr;
#pragma unroll
    for (int j = 0; j < 4; ++j) { const int v0 = 16 * (4 * vh + j) + 4 * fq;
        const f32x4 g4 = g4v[j]; const u32x2 gg = ggv[j];
        const float s0 = bf2f(gg.x & 0xffff), s1 = bf2f(gg.x >> 16), s2 = bf2f(gg.y & 0xffff), s3 = bf2f(gg.y >> 16);
        u32x2 o; o.x = cvt2(o4[j][0] * rinv * g4[0] * (s0 * sigm_(s0)), o4[j][1] * rinv * g4[1] * (s1 * sigm_(s1)));
        o.y = cvt2(o4[j][2] * rinv * g4[2] * (s2 * sigm_(s2)), o4[j][3] * rinv * g4[3] * (s3 * sigm_(s3)));
        *(u32x2*)(O + row * D + h * 128 + v0) = o; }
    }
}

__device__ __forceinline__ void gmlp_mfma(LAS unsigned char* lds, const unsigned char* R, bf16_t* O, const float* lng, const float* lnb, const float* wsp, const float* bsp, int unit, int tid) {
    const int lane = tid & 63, w = __builtin_amdgcn_readfirstlane(tid >> 6), fr = lane & 15, fq = lane >> 4;
    const size_t r0 = (size_t)unit * 128;
    const bf16_t* U = (const bf16_t*)(R + R_U); const bf16_t* VV = (const bf16_t*)(R + R_VV);
    LAS unsigned char* vnt = lds; LAS unsigned char* wt = lds + 34816; LAS float* mu = (LAS float*)(lds + 69632); LAS float* rs = mu + 128;
    __syncthreads();
    for (int i = 0; i < 16; ++i) { const int t = w * 16 + i; const u32x4 x4 = *(const u32x4*)(VV + (r0 + t) * AW + lane * 8);
        float x[8]; x[0] = gelu_(bf2f(x4.x & 0xffff)); x[1] = gelu_(bf2f(x4.x >> 16)); x[2] = gelu_(bf2f(x4.y & 0xffff)); x[3] = gelu_(bf2f(x4.y >> 16)); x[4] = gelu_(bf2f(x4.z & 0xffff)); x[5] = gelu_(bf2f(x4.z >> 16)); x[6] = gelu_(bf2f(x4.w & 0xffff)); x[7] = gelu_(bf2f(x4.w >> 16));
        float s = 0.f;
#pragma unroll
        for (int j = 0; j < 8; ++j) s += x[j];
        const float mean = wave_sum(s) * (1.f / 512.f); float q = 0.f;
#pragma unroll
        for (int j = 0; j < 8; ++j) q += (x[j] - mean) * (x[j] - mean);
        const float rstd = rsqrtf(wave_sum(q) * (1.f / 512.f) + EPS);
        if (lane == 0) { mu[t] = mean; rs[t] = rstd; } }
    __syncthreads();
    for (int g = 0; g < 4; ++g) {
#pragma unroll
        for (int i = 0; i < 4; ++i) { const int idx = tid + 512 * i, s = idx & 127, ch = idx >> 7;
            const u32x4 x4 = *(const u32x4*)(VV + (r0 + s) * AW + g * 128 + ch * 8);
            const f32x4 ga = *(const f32x4*)(lng + g * 128 + ch * 8), gb = *(const f32x4*)(lng + g * 128 + ch * 8 + 4), ba = *(const f32x4*)(lnb + g * 128 + ch * 8), bb = *(const f32x4*)(lnb + g * 128 + ch * 8 + 4);
            const float m_ = mu[s], r_ = rs[s];
            LAS unsigned short* d = (LAS unsigned short*)(vnt + (ch * 8) * QK_STRIDE + s * 2);
            d[0 * (QK_STRIDE / 2)] = (unsigned short)(cvt2((gelu_(bf2f(x4.x & 0xffff)) - m_) * r_ * ga[0] + ba[0], 0.f) & 0xffff);
            d[1 * (QK_STRIDE / 2)] = (unsigned short)(cvt2((gelu_(bf2f(x4.x >> 16)) - m_) * r_ * ga[1] + ba[1], 0.f) & 0xffff);
            d[2 * (QK_STRIDE / 2)] = (unsigned short)(cvt2((gelu_(bf2f(x4.y & 0xffff)) - m_) * r_ * ga[2] + ba[2], 0.f) & 0xffff);
            d[3 * (QK_STRIDE / 2)] = (unsigned short)(cvt2((gelu_(bf2f(x4.y >> 16)) - m_) * r_ * ga[3] + ba[3], 0.f) & 0xffff);
            d[4 * (QK_STRIDE / 2)] = (unsigned short)(cvt2((gelu_(bf2f(x4.z & 0xffff)) - m_) * r_ * gb[0] + bb[0], 0.f) & 0xffff);
            d[5 * (QK_STRIDE / 2)] = (unsigned short)(cvt2((gelu_(bf2f(x4.z >> 16)) - m_) * r_ * gb[1] + bb[1], 0.f) & 0xffff);
            d[6 * (QK_STRIDE / 2)] = (unsigned short)(cvt2((gelu_(bf2f(x4.w & 0xffff)) - m_) * r_ * gb[2] + bb[2], 0.f) & 0xffff);
            d[7 * (QK_STRIDE / 2)] = (unsigned short)(cvt2((gelu_(bf2f(x4.w >> 16)) - m_) * r_ * gb[3] + bb[3], 0.f) & 0xffff); }
#pragma unroll
        for (int i = 0; i < 8; ++i) { const int idx = tid + 512 * i, t = idx >> 5, s0 = (idx & 31) * 4;
            const f32x4 x = *(const f32x4*)(wsp + (size_t)(g * 128 + t) * 128 + s0);
            u32x2 o; o.x = cvt2(s0 <= t ? x[0] : 0.f, s0 + 1 <= t ? x[1] : 0.f); o.y = cvt2(s0 + 2 <= t ? x[2] : 0.f, s0 + 3 <= t ? x[3] : 0.f);
            *(LAS u32x2*)(wt + t * QK_STRIDE + s0 * 2) = o; }
        __syncthreads();
        f32x4 acc[8];
#pragma unroll
        for (int ct = 0; ct < 8; ++ct) acc[ct] = (f32x4){0.f, 0.f, 0.f, 0.f};
        for (int ks = 0; ks <= (w >> 1); ++ks) { const bf16x8 bW = LDFRAG(wt, 16 * w + fr, QK_STRIDE, 32 * ks + 8 * fq);
#pragma unroll
            for (int ct = 0; ct < 8; ++ct) acc[ct] = MFMA16(LDFRAG(vnt, 16 * ct + fr, QK_STRIDE, 32 * ks + 8 * fq), bW, acc[ct]); }
        const int t = 16 * w + fr; const float bt = bsp[g * 128 + t];
#pragma unroll
        for (int ct = 0; ct < 8; ++ct) { const int c0 = g * 128 + 16 * ct + 4 * fq; const u32x2 uu = *(const u32x2*)(U + (r0 + t) * AW + c0);
            u32x2 o; o.x = cvt2(gelu_(bf2f(uu.x & 0xffff)) * (acc[ct][0] + bt), gelu_(bf2f(uu.x >> 16)) * (acc[ct][1] + bt));
            o.y = cvt2(gelu_(bf2f(uu.y & 0xffff)) * (acc[ct][2] + bt), gelu_(bf2f(uu.y >> 16)) * (acc[ct][3] + bt));
            *(u32x2*)(O + (r0 + t) * D + 512 + c0) = o; }
        __syncthreads();
    }
}
__global__ void __launch_bounds__(512, 2) mega(Params p) {
    extern __shared__ __attribute__((aligned(16))) unsigned char lds_raw[];
    LAS unsigned char* lds = (LAS unsigned char*)lds_raw;
    cg::grid_group grid = cg::this_grid();
    const int ph_lo = p.ph_lo, ph_hi = p.ph_hi;
    volatile LAS unsigned* bst = (volatile LAS unsigned*)(lds + 131072 + 1024);
    if (threadIdx.x == 0) { bst[0] = 0u; bst[1] = 0u; }
    __syncthreads();
    const XcdBarrier bar = xcd_barrier_post((unsigned*)(kws() + WS_BAR), bst);
    for (int ph = ph_lo; ph < ph_hi; ++ph) {
        if (ph > ph_lo) {
            if (ph_hi < 0) grid.sync();
            xcd_barrier(bar);
        }
        int tid_ = threadIdx.x; asm volatile("" : "+v"(tid_));
        const int tid = tid_, lane = tid & 63, wave = __builtin_amdgcn_readfirstlane(tid >> 6);
        const int G = gridDim.x, gw = blockIdx.x * 8 + wave, NGW = G * 8;
        unsigned char* ws = kws();
        float* X = kout();
        bf16_t* XB = (bf16_t*)(ws + WS_XB);
        float* SSQ = (float*)(ws + WS_SSQ);
        unsigned char* R = ws + WS_R;
        bf16_t* OB = (bf16_t*)(R + R_O);
        float* LBS = (float*)(ws + WS_LBS);
        if (ph <= PROBE_PREP) {
            LAS float* scr = (LAS float*)(lds + wave * 16384);
            constexpr int IG = 16 * 88, IDN = 44 * 32, IIN = 16 * 96, IOUT = 16 * 32, IL = 6 * IG + IIN + IOUT;
            static_assert(IG == IDN, "items");
            for (int it = gw; it < NLAYER * IL; it += NGW) {
                const int l = it / IL; int r = it % IL;
                unsigned char* wl = ws + (size_t)l * WL_STRIDE;
                const float* W; int K, N, mode = 0; bf16_t* WT; const float* gain = nullptr;
                if (r < IG) { W = kin(2) + (size_t)l * D * FF; K = D; N = FF; WT = (bf16_t*)(wl + WL_GU1); mode = 1; gain = kin(1) + l * D; }
                else if ((r -= IG) < IG) { W = kin(3) + (size_t)l * D * FF; K = D; N = FF; WT = (bf16_t*)(wl + WL_GU1); mode = 2; gain = kin(1) + l * D; }
                else if ((r -= IG) < IDN) { W = kin(4) + (size_t)l * D * FF; K = FF; N = D; WT = (bf16_t*)(wl + WL_DN1); }
                else if ((r -= IDN) < IIN) { W = kin(6) + (size_t)l * D * DIN; K = D; N = DIN; WT = (bf16_t*)(wl + WL_WIN); gain = kin(5) + l * D; }
                else if ((r -= IIN) < IOUT) { W = kin(13) + (size_t)l * D * D; K = D; N = D; WT = (bf16_t*)(wl + WL_WOUT); }
                else if ((r -= IOUT) < IG) { W = kin(15) + (size_t)l * D * FF; K = D; N = FF; WT = (bf16_t*)(wl + WL_GU2); mode = 1; gain = kin(14) + l * D; }
                else if ((r -= IG) < IG) { W = kin(16) + (size_t)l * D * FF; K = D; N = FF; WT = (bf16_t*)(wl + WL_GU2); mode = 2; gain = kin(14) + l * D; }
                else { r -= IG; W = kin(17) + (size_t)l * D * FF; K = FF; N = D; WT = (bf16_t*)(wl + WL_DN2); }
                const int nblk = N / 32, kb = r / nblk, nb = r % nblk, k0 = 64 * kb, n0 = 32 * nb;
                const int drow0 = mode == 0 ? n0 : ((n0 >> 7) * 256 + (n0 & 127) + (mode == 2 ? 128 : 0));
                transpose_item(W, K, N, WT, k0, n0, drow0, gain, scr, lane);
            }
            if (blockIdx.x == 0) { const float a0 = kin(7)[tid], a1 = kin(7)[AW + tid]; LBS[tid] = 0.f; LBS[AW + tid] = 1.0f / (1.0f + __expf(a0 - a1)); }
            for (int m = gw; m < M; m += NGW) row_to_xb(kin(0) + (size_t)m * D, XB + (size_t)m * D, SSQ + (size_t)m * 16, lane);
            continue;
        }
        if (ph >= NPHASE - 1 - PROBE_SYNCS && ph < NPHASE - 1) continue;
        if (ph == NPHASE - 1) {
            for (int m = gw; m < M; m += NGW) final_norm_row(XB + (size_t)m * D, X + (size_t)m * D, kin(18), SSQ, m, lane);
            continue;
        }
#ifdef PROBE_DUP_S
        const int q = ph - 1 - PROBE_PREP, l = q / 10, s0 = q % 10, s = s0 <= PROBE_DUP_S ? s0 : s0 - 1;
        if ((PROBE_DUP_S == 1 || PROBE_DUP_S == 6 || PROBE_DUP_S == 8) && s0 == PROBE_DUP_S + 1 && !(l == 0 && PROBE_DUP_S == 1)) continue;
#else
        const int q = ph - 1 - PROBE_PREP, l = q / 9, s = q % 9;
#endif
        unsigned char* wl = ws + (size_t)l * WL_STRIDE;
        if (s == 0 || s == 7) {
            pg8::Gemm g{XB, (const bf16_t*)(wl + (s == 0 ? WL_GU1 : WL_GU2)), M, 2 * FF, D}; pg8::StaticOrder S; S.init(M, 2 * FF, G, (int)blockIdx.x);
            *(LAS f32x4*)(lds + pg8::RINV_LDS_OFF + tid * 48 + 32) = (f32x4){0.f, 0.f, 0.f, 0.f};
            pg8::EpiSwiGLU E{(bf16_t*)R, FF, SSQ, lds};
            pg8::gemm_phase<pg8::EpiSwiGLU, pg8::StaticOrder, true, true>(lds, g, S, E);
        } else if (s == 1 || s == 8 || s == 6) {
            const bf16_t* A = (s == 6) ? OB : (const bf16_t*)R; const int K = (s == 6) ? D : FF;
            const bf16_t* Bt = (const bf16_t*)(wl + (s == 6 ? WL_WOUT : (s == 1 ? WL_DN1 : WL_DN2)));
            const float* base32 = (l == 0 && s == 1) ? kin(0) : nullptr; float* out32 = nullptr;
            pg8::Gemm g{A, Bt, M, D, K}; pg8::StaticOrder S; S.init(M, D, G, (int)blockIdx.x);
            pg8::EpiResid E{base32, out32, XB, SSQ, D, s == 6 ? 1.0f : 0.5f};
            pg8::gemm_phase<pg8::EpiResid, pg8::StaticOrder, true, true>(lds, g, S, E);
        } else if (s == 2) {
            pg8::Gemm g{XB, (const bf16_t*)(wl + WL_WIN), M, DIN, D}; pg8::StaticOrder S; S.init(M, DIN, G, (int)blockIdx.x);
            *(LAS f32x4*)(lds + pg8::RINV_LDS_OFF + tid * 48 + 32) = (f32x4){0.f, 0.f, 0.f, 0.f};
            pg8::EpiMix E{R, LBS + l * AW, SSQ, lds};
            pg8::gemm_phase<pg8::EpiMix, pg8::StaticOrder, true, true>(lds, g, S, E);
        } else if (s == 3) {
            float* DBUF = (float*)(ws + WS_DBUF);
            hgrn_pass1_all(lds, R, (bf16_t*)X, DBUF, LBS + l * AW, (int)blockIdx.x, G, tid);
            for (int u = blockIdx.x; u < NB * 64; u += G)
                gmlp_mfma(lds, R, OB, kin(9) + l * AW, kin(10) + l * AW, kin(11) + (size_t)l * 4 * 128 * 128, kin(12) + l * 4 * 128, u, tid);
        } else if (s == 4) {
            for (int it = blockIdx.x; it < 256; it += G) hgrn_scan((unsigned*)X, (const float*)(ws + WS_DBUF), it, tid);
        } else if (s == 5) {
            hgrn_pass3_all(lds, R, (const bf16_t*)X, OB, kin(8) + l * AW, LBS + l * AW, (int)blockIdx.x, G, tid);
        }
    }
}

#ifndef MK_COOP
#define MK_COOP 1
#endif
extern "C" void kernel_launch(void* const* d_in, const int* in_sizes, int n_in, void* d_out, int out_size, void* d_ws, size_t ws_size, hipStream_t stream) {
    static int grid = 0;
    if (grid == 0) {
        if (n_in != 19 || out_size != M * D || ws_size < WS_END) { fprintf(stderr, "kernel_launch: unexpected sizes n_in %d out %d ws %zu\n", n_in, out_size, ws_size); grid = -1; return; }
        int dev = 0, cus = 0, per_cu = 0;
        hipGetDevice(&dev); hipDeviceGetAttribute(&cus, hipDeviceAttributeMultiprocessorCount, dev);
        if (hipFuncSetAttribute((const void*)mega, hipFuncAttributeMaxDynamicSharedMemorySize, LDS_BYTES) != hipSuccess) { fprintf(stderr, "kernel_launch: hipFuncSetAttribute failed\n"); grid = -1; return; }
        if (hipOccupancyMaxActiveBlocksPerMultiprocessor(&per_cu, (const void*)mega, 512, LDS_BYTES) != hipSuccess || per_cu < 1) { fprintf(stderr, "kernel_launch: occupancy query says %d\n", per_cu); per_cu = 1; }
        (void)hipGetLastError();
        grid = cus * per_cu;
    }
    if (grid < 0) return;
    Params a{};
    for (int i = 0; i < 19; ++i) a.in[i] = (const float*)d_in[i];
    a.out = (float*)d_out; a.ws = (unsigned char*)d_ws;
    if (hipMemsetAsync((char*)d_ws + WS_BAR, 0, BAR_BYTES, stream) != hipSuccess) { fprintf(stderr, "kernel_launch: memset of the barrier words failed\n"); return; }
#if MK_COOP
    a.ph_lo = 0; a.ph_hi = NPHASE;
    void* args[] = {&a};
    hipError_t e = hipLaunchCooperativeKernel((const void*)mega, dim3(grid), dim3(512), args, LDS_BYTES, stream);
    if (e != hipSuccess) fprintf(stderr, "cooperative launch failed: %s (grid %d)\n", hipGetErrorString(e), grid);
#else
    for (int ph = 0; ph < NPHASE; ++ph) { a.ph_lo = ph; a.ph_hi = ph + 1; hipLaunchKernelGGL(mega, dim3(grid), dim3(512), LDS_BYTES, stream, a); }
#endif
}
```
